# Optimizing an MI355X kernel written in HIP

```python
import jax
import jax.numpy as jnp
from jax import lax
import numpy as np

D_MODEL = 2048
BATCH = 2
SEQ = 16384
DEPTH = 4

CTX_LEN = 256
GRID_W = 64
N_MIXERS = 4
NORM_EPS = 1e-6
ROPE_THETA = 10000.0
FFN_HIDDEN = ((8 * D_MODEL + 3 * 256 - 1) // (3 * 256)) * 256

LRU_WIDTH = D_MODEL
LRU_BLOCKS = 16
LRU_BLOCK = LRU_WIDTH // LRU_BLOCKS
LRU_C = 8.0
CONV_WIDTH = 4
CONV_PAD_LEFT = 2
CONV_PAD_RIGHT = CONV_WIDTH - 1 - CONV_PAD_LEFT

HGRN_HEAD_DIM = 128
HGRN_HEADS = D_MODEL // HGRN_HEAD_DIM
HGRN_WIDTH = HGRN_HEADS * HGRN_HEAD_DIM
GLA_CHUNK = 64

MLA_HEADS = 16
MLA_Q_RANK = 512
MLA_KV_RANK = 512
MLA_NOPE = 128
MLA_ROPE = 64
MLA_V = 128
MLA_SCALE = (MLA_NOPE + MLA_ROPE) ** -0.5
Q_BLOCK = 128

SWA_Q_HEADS = 16
SWA_KV_HEADS = 4
SWA_GROUP = SWA_Q_HEADS // SWA_KV_HEADS
SWA_HEAD_DIM = 128
SWA_WINDOW = 128
SWA_BLOCK = 128
SWA_SCALE = SWA_HEAD_DIM ** -0.5

kernel_name = 'hybrid_interleaved_diffusion_trunk'


def rms_norm(x, g):
    xf = x.astype(jnp.float32)
    y = xf * lax.rsqrt(jnp.mean(xf * xf, axis=-1, keepdims=True) + NORM_EPS)
    return (y * g.astype(jnp.float32)).astype(x.dtype)


def adaln(x, g, shift, scale):
    return rms_norm(x, g) * (1.0 + scale) + shift


def swiglu(h, w_in, w_out):
    gate, up = jnp.split(h @ w_in, 2, axis=-1)
    return (jax.nn.silu(gate) * up) @ w_out


def axial_rope_tables(row, col, rot_dim):
    n_freq = rot_dim // 4
    inv = ROPE_THETA ** (-jnp.arange(n_freq, dtype=jnp.float32) / n_freq)
    ang_r = row.astype(jnp.float32)[:, None] * inv[None, :]
    ang_c = col.astype(jnp.float32)[:, None] * inv[None, :]
    return (jnp.cos(ang_r), jnp.sin(ang_r), jnp.cos(ang_c), jnp.sin(ang_c))


def _rotate_half(x, cos, sin):
    x1, x2 = jnp.split(x, 2, axis=-1)
    return jnp.concatenate([x1 * cos - x2 * sin, x1 * sin + x2 * cos], axis=-1)


def apply_axial_rope(x, tables):
    cos_r, sin_r, cos_c, sin_c = tables
    shape = (1, cos_r.shape[0]) + (1,) * (x.ndim - 3) + (cos_r.shape[1],)
    f = lambda t: t.reshape(shape).astype(x.dtype)
    x_row, x_col = jnp.split(x, 2, axis=-1)
    return jnp.concatenate([_rotate_half(x_row, f(cos_r), f(sin_r)),
                            _rotate_half(x_col, f(cos_c), f(sin_c))], axis=-1)


def centred_depthwise_conv(u, w, b):
    y = lax.conv_general_dilated(u, w[:, None, :].astype(u.dtype), window_strides=(1,),
                                 padding=[(CONV_PAD_LEFT, CONV_PAD_RIGHT)],
                                 dimension_numbers=('NWC', 'WIO', 'NWC'),
                                 feature_group_count=u.shape[-1])
    return y + b


def rglru_coeffs(u, gate_w, gate_b, lam):
    b, n, w = u.shape
    ub = u.reshape(b, n, LRU_BLOCKS, LRU_BLOCK)
    gates = jnp.einsum('bnkc,gkcd->gbnkd', ub, gate_w).reshape(2, b, n, w) + gate_b[:, None, None, :]
    gates = gates.astype(jnp.float32)
    r = jax.nn.sigmoid(gates[0])
    i = jax.nn.sigmoid(gates[1])
    log_a = -LRU_C * r * jax.nn.softplus(-lam.astype(jnp.float32))
    a = jnp.exp(log_a)
    bx = jnp.sqrt(-jnp.expm1(2.0 * log_a)) * (i * u.astype(jnp.float32))
    return a, bx


def linear_scan(a, b, h0, reverse):
    if h0 is not None:
        edge = -1 if reverse else 0
        b = b.at[:, edge].add(a[:, edge] * h0)

    def combine(e1, e2):
        a1, b1 = e1
        a2, b2 = e2
        return a1 * a2, a2 * b1 + b2

    return lax.associative_scan(combine, (a, b), axis=1, reverse=reverse)[1]


def rglru_mixer(h_ctx, h_lat, w_in, conv_w, conv_b, gate_w, gate_b, lam, w_out, need_ctx):
    def branches(h):
        gate_in, rec_in = jnp.split(h @ w_in, 2, axis=-1)
        return gate_in, centred_depthwise_conv(rec_in, conv_w, conv_b)

    g_ctx, u_ctx = branches(h_ctx)
    g_lat, u_lat = branches(h_lat)
    ys_ctx, ys_lat = [], []
    for d, reverse in enumerate((False, True)):
        a, bx = rglru_coeffs(u_ctx, gate_w[d], gate_b[d], lam[d])
        hc = linear_scan(a, bx, None, reverse)
        h_end = hc[:, 0] if reverse else hc[:, -1]
        a, bx = rglru_coeffs(u_lat, gate_w[d], gate_b[d], lam[d])
        ys_lat.append(linear_scan(a, bx, h_end, reverse))
        ys_ctx.append(hc)
    y_lat = (jax.nn.gelu(g_lat) * (ys_lat[0] + ys_lat[1]).astype(g_lat.dtype)) @ w_out
    y_ctx = None
    if need_ctx:
        y_ctx = (jax.nn.gelu(g_ctx) * (ys_ctx[0] + ys_ctx[1]).astype(g_ctx.dtype)) @ w_out
    return y_ctx, y_lat


def hgrn_lower_bounds(logits):
    cum = jnp.cumsum(jax.nn.softmax(logits.astype(jnp.float32), axis=0), axis=0)
    return cum - cum[:1]


def gla_chunk_scan(q, k, v, log_f, s0):
    b, n, h, _ = q.shape
    nc = n // GLA_CHUNK
    to_chunks = lambda t: t.reshape(b, nc, GLA_CHUNK, h, t.shape[-1]).transpose(1, 0, 3, 2, 4)
    tri = jnp.tril(jnp.ones((GLA_CHUNK, GLA_CHUNK), dtype=bool))

    def step(state, blk):
        qc, kc, vc, gc = blk
        cum = jnp.cumsum(gc, axis=2)
        rel = jnp.where(tri[:, :, None], cum[:, :, :, None, :] - cum[:, :, None, :, :], -jnp.inf)
        scores = jnp.einsum('bhtd,bhsd,bhtsd->bhts', qc, kc, jnp.exp(rel))
        o = (jnp.einsum('bhts,bhse->bhte', scores, vc)
             + jnp.einsum('bhtd,bhde->bhte', qc * jnp.exp(cum), state))
        last = cum[:, :, -1:, :]
        new_state = (jnp.exp(last)[:, :, 0, :, None] * state
                     + jnp.einsum('bhsd,bhse->bhde', kc * jnp.exp(last - cum), vc))
        return new_state, o

    state, o = lax.scan(step, s0, (to_chunks(q), to_chunks(k), to_chunks(v), to_chunks(log_f)))
    return o.transpose(1, 0, 3, 2, 4).reshape(b, n, h, v.shape[-1]), state


def hgrn2_mixer(h_ctx, h_lat, w_in, lb, gnorm_g, w_out, need_ctx):
    def project(h):
        b, n, _ = h.shape
        q, f_fw, f_bw, i, g = jnp.split(h @ w_in, 5, axis=-1)
        heads = lambda t: t.reshape(b, n, HGRN_HEADS, HGRN_HEAD_DIM).astype(jnp.float32)
        forget = []
        for d, z in enumerate((f_fw, f_bw)):
            lbd = lb[d].reshape(HGRN_HEADS, HGRN_HEAD_DIM)
            forget.append(lbd + (1.0 - lbd) * jax.nn.sigmoid(heads(z)))
        return jax.nn.silu(heads(q)), forget, heads(i), g

    q_c, f_c, i_c, g_c = project(h_ctx)
    q_l, f_l, i_l, g_l = project(h_lat)
    s0 = jnp.zeros((h_lat.shape[0], HGRN_HEADS, HGRN_HEAD_DIM, HGRN_HEAD_DIM), jnp.float32)
    outs_ctx, outs_lat = [], []
    for d in range(2):
        orient = (lambda t: jnp.flip(t, axis=1)) if d == 1 else (lambda t: t)
        o_c, s_c = gla_chunk_scan(orient(q_c), orient(1.0 - f_c[d]), orient(i_c), orient(jnp.log(f_c[d])), s0)
        o_l, _ = gla_chunk_scan(orient(q_l), orient(1.0 - f_l[d]), orient(i_l), orient(jnp.log(f_l[d])), s_c)
        outs_ctx.append(orient(o_c))
        outs_lat.append(orient(o_l))

    def readout(o, g):
        b, n = o.shape[:2]
        o = rms_norm(o, gnorm_g).reshape(b, n, HGRN_WIDTH).astype(g.dtype)
        return (o * jax.nn.silu(g)) @ w_out

    y_lat = readout(outs_lat[0] + outs_lat[1], g_l)
    y_ctx = readout(outs_ctx[0] + outs_ctx[1], g_c) if need_ctx else None
    return y_ctx, y_lat


def blocked_softmax_attention(q, k, v, scale):
    b, n, h, dq = q.shape
    nb = n // Q_BLOCK
    qb = jnp.moveaxis(q.reshape(b, nb, Q_BLOCK, h, dq), 1, 0)

    def one_block(qblk):
        s = jnp.einsum('bqhd,bkhd->bhqk', qblk, k).astype(jnp.float32) * scale
        p = jax.nn.softmax(s, axis=-1).astype(v.dtype)
        return jnp.einsum('bhqk,bkhd->bqhd', p, v)

    o = lax.map(one_block, qb)
    return jnp.moveaxis(o, 0, 1).reshape(b, n, h, v.shape[-1])


def mla_mixer(h_ctx, h_lat, w_in, q_norm_g, kv_norm_g, w_uq, w_ukv, qk_g, w_out, rope_tab, need_ctx):
    def qkv(h, tab):
        b, n, _ = h.shape
        cq, ckv, k_rope = jnp.split(h @ w_in, [MLA_Q_RANK, MLA_Q_RANK + MLA_KV_RANK], axis=-1)
        q = (rms_norm(cq, q_norm_g) @ w_uq).reshape(b, n, MLA_HEADS, MLA_NOPE + MLA_ROPE)
        kv = (rms_norm(ckv, kv_norm_g) @ w_ukv).reshape(b, n, MLA_HEADS, MLA_NOPE + MLA_V)
        q_nope, q_rope = jnp.split(q, [MLA_NOPE], axis=-1)
        k_nope, v = jnp.split(kv, [MLA_NOPE], axis=-1)
        k_rope = k_rope[:, :, None, :]
        q_nope = rms_norm(q_nope, qk_g[0, :MLA_NOPE])
        q_rope = rms_norm(q_rope, qk_g[0, MLA_NOPE:])
        k_nope = rms_norm(k_nope, qk_g[1, :MLA_NOPE])
        k_rope = rms_norm(k_rope, qk_g[1, MLA_NOPE:])
        if tab is not None:
            q_rope = apply_axial_rope(q_rope, tab)
            k_rope = apply_axial_rope(k_rope, tab)
        q = jnp.concatenate([q_nope, q_rope], axis=-1)
        k = jnp.concatenate([k_nope, jnp.broadcast_to(k_rope, (b, n, MLA_HEADS, MLA_ROPE))], axis=-1)
        return q, k, v

    q_c, k_c, v_c = qkv(h_ctx, None)
    q_l, k_l, v_l = qkv(h_lat, rope_tab)
    b, n = h_lat.shape[:2]
    o_l = blocked_softmax_attention(q_l, jnp.concatenate([k_c, k_l], axis=1),
                                    jnp.concatenate([v_c, v_l], axis=1), MLA_SCALE)
    y_lat = o_l.reshape(b, n, MLA_HEADS * MLA_V) @ w_out
    y_ctx = None
    if need_ctx:
        o_c = blocked_softmax_attention(q_c, k_c, v_c, MLA_SCALE)
        y_ctx = o_c.reshape(b, h_ctx.shape[1], MLA_HEADS * MLA_V) @ w_out
    return y_ctx, y_lat


def attend_with_sink(q, keys, values, masks, sink):
    b, nq = q.shape[:2]
    logits = [jnp.broadcast_to(sink.astype(jnp.float32).reshape(SWA_KV_HEADS, SWA_GROUP)[None, :, :, None, None],
                               (b, SWA_KV_HEADS, SWA_GROUP, nq, 1))]
    for k, m in zip(keys, masks):
        s = jnp.einsum('bqhgd,bkhd->bhgqk', q, k).astype(jnp.float32) * SWA_SCALE
        logits.append(s if m is None else jnp.where(m, s, -jnp.inf))
    p = jax.nn.softmax(jnp.concatenate(logits, axis=-1), axis=-1)
    out = None
    start = 1
    for k, v in zip(keys, values):
        width = k.shape[1]
        part = jnp.einsum('bhgqk,bkhd->bqhgd', p[..., start:start + width].astype(v.dtype), v)
        out = part if out is None else out + part
        start += width
    return out


def swa_mixer(h_ctx, h_lat, w_in, qk_g, sink, w_out, rope_tab, need_ctx):
    def qkv(h, tab):
        b, n, _ = h.shape
        q, k, v = jnp.split(h @ w_in, [SWA_Q_HEADS * SWA_HEAD_DIM, (SWA_Q_HEADS + SWA_KV_HEADS) * SWA_HEAD_DIM], axis=-1)
        q = rms_norm(q.reshape(b, n, SWA_KV_HEADS, SWA_GROUP, SWA_HEAD_DIM), qk_g[0])
        k = rms_norm(k.reshape(b, n, SWA_KV_HEADS, SWA_HEAD_DIM), qk_g[1])
        v = v.reshape(b, n, SWA_KV_HEADS, SWA_HEAD_DIM)
        if tab is not None:
            q = apply_axial_rope(q, tab)
            k = apply_axial_rope(k, tab)
        return q, k, v

    q_c, k_c, v_c = qkv(h_ctx, None)
    q_l, k_l, v_l = qkv(h_lat, rope_tab)
    b, n = h_lat.shape[:2]
    nb = n // SWA_BLOCK
    pad = ((0, 0), (SWA_BLOCK, SWA_BLOCK), (0, 0), (0, 0))
    k_pad, v_pad = jnp.pad(k_l, pad), jnp.pad(v_l, pad)
    q_blocks = jnp.moveaxis(q_l.reshape(b, nb, SWA_BLOCK, SWA_KV_HEADS, SWA_GROUP, SWA_HEAD_DIM), 1, 0)
    band = 3 * SWA_BLOCK
    offset = jnp.arange(SWA_BLOCK)[:, None] + SWA_BLOCK - jnp.arange(band)[None, :]
    in_window = jnp.abs(offset) <= SWA_WINDOW

    def one_block(args):
        j, q_blk = args
        start = j * SWA_BLOCK
        k_band = lax.dynamic_slice_in_dim(k_pad, start, band, axis=1)
        v_band = lax.dynamic_slice_in_dim(v_pad, start, band, axis=1)
        key_pos = start - SWA_BLOCK + jnp.arange(band)
        mask = in_window & ((key_pos >= 0) & (key_pos < n))[None, :]
        return attend_with_sink(q_blk, (k_c, k_band), (v_c, v_band), (None, mask), sink)

    o_l = lax.map(one_block, (jnp.arange(nb), q_blocks))
    y_lat = jnp.moveaxis(o_l, 0, 1).reshape(b, n, SWA_Q_HEADS * SWA_HEAD_DIM) @ w_out
    y_ctx = None
    if need_ctx:
        o_c = attend_with_sink(q_c, (k_c,), (v_c,), (None,), sink)
        y_ctx = o_c.reshape(b, h_ctx.shape[1], SWA_Q_HEADS * SWA_HEAD_DIM) @ w_out
    return y_ctx, y_lat


def setup_inputs(seed: int = 0) -> dict:
    key = jax.random.key(seed)
    keys = iter(jax.random.split(key, 48))

    def normal(shape, scale):
        return scale * jax.random.normal(next(keys), shape, jnp.float32)

    def gain(shape):
        return 1.0 + normal(shape, 0.05)

    n_a, n_b, n_c, n_d = (len(range(m, DEPTH, N_MIXERS)) for m in range(N_MIXERS))
    D = D_MODEL
    lam_u = jax.random.uniform(next(keys), (n_a, 2, LRU_WIDTH), jnp.float32, 0.9, 0.999)
    lam_p = lam_u ** (1.0 / LRU_C)
    return {
        'x': normal((BATCH, SEQ, D), 1.0),
        'c': normal((BATCH, D), 1.0),
        'ctx': normal((BATCH, CTX_LEN, D), 1.0),
        'c_ctx': normal((D,), 1.0),
        'mod_w': normal((DEPTH, D, 6 * D), 0.5 * D ** -0.5),
        'mod_b': normal((DEPTH, 6 * D), 0.1),
        'norm_g': gain((DEPTH, 2, D)),
        'ffn_w_in': normal((DEPTH, D, 2 * FFN_HIDDEN), D ** -0.5),
        'ffn_w_out': normal((DEPTH, FFN_HIDDEN, D), FFN_HIDDEN ** -0.5),
        'rglru_w_in': normal((n_a, D, 2 * LRU_WIDTH), D ** -0.5),
        'rglru_conv_w': normal((n_a, CONV_WIDTH, LRU_WIDTH), CONV_WIDTH ** -0.5),
        'rglru_conv_b': normal((n_a, LRU_WIDTH), 0.02),
        'rglru_gate_w': normal((n_a, 2, 2, LRU_BLOCKS, LRU_BLOCK, LRU_BLOCK), LRU_BLOCK ** -0.5),
        'rglru_gate_b': normal((n_a, 2, 2, LRU_WIDTH), 0.02),
        'rglru_lambda': jnp.log(lam_p) - jnp.log1p(-lam_p),
        'rglru_w_out': normal((n_a, LRU_WIDTH, D), LRU_WIDTH ** -0.5),
        'hgrn_w_in': normal((n_b, D, 5 * HGRN_WIDTH), D ** -0.5),
        'hgrn_lb_logits': normal((DEPTH, 2, HGRN_WIDTH), 0.1),
        'hgrn_gnorm_g': gain((n_b, HGRN_HEAD_DIM)),
        'hgrn_w_out': normal((n_b, HGRN_WIDTH, D), HGRN_WIDTH ** -0.5),
        'mla_w_in': normal((n_c, D, MLA_Q_RANK + MLA_KV_RANK + MLA_ROPE), D ** -0.5),
        'mla_q_norm_g': gain((n_c, MLA_Q_RANK)),
        'mla_kv_norm_g': gain((n_c, MLA_KV_RANK)),
        'mla_w_uq': normal((n_c, MLA_Q_RANK, MLA_HEADS * (MLA_NOPE + MLA_ROPE)), MLA_Q_RANK ** -0.5),
        'mla_w_ukv': normal((n_c, MLA_KV_RANK, MLA_HEADS * (MLA_NOPE + MLA_V)), MLA_KV_RANK ** -0.5),
        'mla_qk_g': gain((n_c, 2, MLA_NOPE + MLA_ROPE)),
        'mla_w_out': normal((n_c, MLA_HEADS * MLA_V, D), (MLA_HEADS * MLA_V) ** -0.5),
        'swa_w_in': normal((n_d, D, (SWA_Q_HEADS + 2 * SWA_KV_HEADS) * SWA_HEAD_DIM), D ** -0.5),
        'swa_qk_g': gain((n_d, 2, SWA_HEAD_DIM)),
        'swa_sink': normal((n_d, SWA_Q_HEADS), 0.5),
        'swa_w_out': normal((n_d, SWA_Q_HEADS * SWA_HEAD_DIM, D), (SWA_Q_HEADS * SWA_HEAD_DIM) ** -0.5),
    }


def reference(x, c, ctx, c_ctx, mod_w, mod_b, norm_g, ffn_w_in, ffn_w_out,
              rglru_w_in, rglru_conv_w, rglru_conv_b, rglru_gate_w, rglru_gate_b, rglru_lambda, rglru_w_out,
              hgrn_w_in, hgrn_lb_logits, hgrn_gnorm_g, hgrn_w_out,
              mla_w_in, mla_q_norm_g, mla_kv_norm_g, mla_w_uq, mla_w_ukv, mla_qk_g, mla_w_out,
              swa_w_in, swa_qk_g, swa_sink, swa_w_out):
    n_lat = x.shape[1]
    rows = n_lat // GRID_W
    row = jnp.repeat(jnp.arange(rows), GRID_W)
    col = jnp.tile(jnp.arange(GRID_W), rows)
    rope_mla = axial_rope_tables(row, col, MLA_ROPE)
    rope_swa = axial_rope_tables(row, col, SWA_HEAD_DIM)
    lower_bounds = hgrn_lower_bounds(hgrn_lb_logits)
    cond_lat = jax.nn.silu(c)[:, None, :]
    cond_ctx = jax.nn.silu(c_ctx)[None, None, :]
    x_lat, x_ctx = x, ctx
    for layer in range(DEPTH):
        kind, slot = layer % N_MIXERS, layer // N_MIXERS
        need_ctx = layer < DEPTH - 1
        m_lat = jnp.split(cond_lat @ mod_w[layer] + mod_b[layer], 6, axis=-1)
        m_ctx = jnp.split(cond_ctx @ mod_w[layer] + mod_b[layer], 6, axis=-1)
        h_lat = adaln(x_lat, norm_g[layer, 0], m_lat[0], m_lat[1])
        h_ctx = adaln(x_ctx, norm_g[layer, 0], m_ctx[0], m_ctx[1])
        if kind == 0:
            y_ctx, y_lat = rglru_mixer(h_ctx, h_lat, rglru_w_in[slot], rglru_conv_w[slot], rglru_conv_b[slot],
                                       rglru_gate_w[slot], rglru_gate_b[slot], rglru_lambda[slot],
                                       rglru_w_out[slot], need_ctx)
        elif kind == 1:
            y_ctx, y_lat = hgrn2_mixer(h_ctx, h_lat, hgrn_w_in[slot], lower_bounds[layer], hgrn_gnorm_g[slot],
                                       hgrn_w_out[slot], need_ctx)
        elif kind == 2:
            y_ctx, y_lat = mla_mixer(h_ctx, h_lat, mla_w_in[slot], mla_q_norm_g[slot], mla_kv_norm_g[slot],
                                     mla_w_uq[slot], mla_w_ukv[slot], mla_qk_g[slot], mla_w_out[slot],
                                     rope_mla, need_ctx)
        else:
            y_ctx, y_lat = swa_mixer(h_ctx, h_lat, swa_w_in[slot], swa_qk_g[slot], swa_sink[slot],
                                     swa_w_out[slot], rope_swa, need_ctx)
        x_lat = x_lat + m_lat[2] * y_lat
        f_lat = adaln(x_lat, norm_g[layer, 1], m_lat[3], m_lat[4])
        x_lat = x_lat + m_lat[5] * swiglu(f_lat, ffn_w_in[layer], ffn_w_out[layer])
        if need_ctx:
            x_ctx = x_ctx + m_ctx[2] * y_ctx
            f_ctx = adaln(x_ctx, norm_g[layer, 1], m_ctx[3], m_ctx[4])
            x_ctx = x_ctx + m_ctx[5] * swiglu(f_ctx, ffn_w_in[layer], ffn_w_out[layer])
    return x_lat
```

```cpp
#include <hip/hip_runtime.h>
#include <cstdio>
#include <cstdint>
namespace pg8 {
#define PG8_LAS __attribute__((address_space(3)))
typedef unsigned short bf16_t;
typedef short bf16x8 __attribute__((ext_vector_type(8)));
typedef float f32x4 __attribute__((ext_vector_type(4)));
typedef unsigned u32x4 __attribute__((ext_vector_type(4)));
constexpr int BM = 256, BK = 64, HALF = 128, HTB = HALF * BK * 2  , STAGE_BYTES = 8 * HTB, NXCD = 8;

__host__ __device__ __forceinline__ int lds_byte(int r, int c) { const int st = (r >> 4) * 2 + (c >> 5), rr = r & 15, cc = c & 31, ob = rr * 64 + cc * 2; return st * 1024 + (ob ^ (((ob >> 9) & 1) << 5)); }
__host__ __device__ __forceinline__ void stage_rc(int b, int& R, int& C) { const int st = b / 1024, sb = b % 1024, swz = sb ^ (((sb >> 9) & 1) << 5); R = (st >> 1) * 16 + swz / 64; C = (st & 1) * 32 + (swz % 64) / 2; }
__host__ __device__ __forceinline__ int perm32(int rho) { const int n = rho >> 4, i = rho & 15; return 8 * (i >> 2) + 4 * n + (i & 3); }

struct Unit { int pm, pn, ko; };
struct Gemm { const bf16_t* A; const bf16_t* Bt; int M, N, K, ld; };

struct StaticOrder {
    int nM, nN, nwg, G, c, WGM, pm0, rev;
    __host__ __device__ void init(int M, int N, int G_, int c_, int wgm_ = 4, int pm0_ = 0, int rev_ = 0) { nM = M / BM; nN = N / BM; nwg = nM * nN; G = G_; c = c_; WGM = wgm_; pm0 = pm0_; rev = rev_; }
    __host__ __device__ bool next(int i, Unit& u) const {
        const long L = (long)i * G + c; if (L >= nwg) return false;
        int wgid = (int)L; { const int q = nwg / NXCD, r = nwg % NXCD, xcd = wgid % NXCD; int off = wgid / NXCD; if (rev) off = (xcd < r ? q : q - 1) - off; wgid = (xcd < r ? xcd * (q + 1) : r * (q + 1) + (xcd - r) * q) + off; }
        const int nig = WGM * nN, gid = wgid / nig, fm = gid * WGM, gsz = (nM - fm) < WGM ? (nM - fm) : WGM;
        u.pm = pm0 + fm + ((wgid % nig) % gsz); u.pn = (wgid % nig) / gsz; u.ko = 0; return true;
    }
    __device__ __forceinline__ void a_ready(const Unit&) const {}
    __device__ __forceinline__ void done(const Unit&) const {}
};

__device__ __forceinline__ unsigned cvt_pk_bf16(float lo, float hi) { unsigned r; asm volatile("v_cvt_pk_bf16_f32 %0, %1, %2" : "=v"(r) : "v"(lo), "v"(hi)); return r; }
typedef float f32x2 __attribute__((ext_vector_type(2)));
__device__ __forceinline__ f32x2 gelu_pk(f32x2 v) {
    const f32x2 av = __builtin_elementwise_abs(v), d = av * 0.2316418882f + 1.0f;
    f32x2 t; t.x = __builtin_amdgcn_rcpf(d.x); t.y = __builtin_amdgcn_rcpf(d.y);
    f32x2 q = t * 0.5307027145f + (-0.7265760135f); q = q * t + 0.7107068705f; q = q * t + (-0.142248368f); q = q * t + 0.127414796f; q = q * t;
    const f32x2 s = (v * v) * (-0.72134752044f);
    f32x2 e; e.x = __builtin_amdgcn_exp2f(s.x); e.y = __builtin_amdgcn_exp2f(s.y);
    const f32x2 m = v * (q * e), r = v - m;
    f32x2 o; o.x = v.x < 0.f ? m.x : r.x; o.y = v.y < 0.f ? m.y : r.y; return o;
}

template <int ACT  > struct EpiBf16 {
    static constexpr bool PERM = true, AFTER_DRAIN = false; static_assert(ACT == 0 || ACT == 1, "EpiBf16: ACT is 0 (none) or 1 (gelu_pk)");
    bf16_t* O; int ldc; const float* bias; int split_cols; size_t split_stride; float scale0;
    __device__ __forceinline__ void operator()(const f32x4 (&acc)[2][2][4][2], const Unit& u, int wr, int wc, int fr, int fq) const {
        const int row0 = u.pm * BM + wr * 64 + fr; int colt = u.pn * BM; bf16_t* base = O;
        float sc = 1.f; if (split_cols) { const int t = colt / split_cols; base += (size_t)t * split_stride; colt -= t * split_cols; if (t == 0) sc = scale0; }
        const int col0 = colt + wc * 32 + 8 * fq, bcol0 = u.pn * BM + wc * 32 + 8 * fq;
        f32x4 bv[2][2];
#pragma unroll
        for (int bj = 0; bj < 2; ++bj)
#pragma unroll
            for (int n = 0; n < 2; ++n) bv[bj][n] = bias ? *(const f32x4*)(bias + bcol0 + bj * HALF + 4 * n) : (f32x4){0.f, 0.f, 0.f, 0.f};
#pragma unroll
        for (int ai = 0; ai < 2; ++ai)
#pragma unroll
            for (int m = 0; m < 4; ++m) { bf16_t* rowp = base + (size_t)(row0 + ai * HALF + m * 16) * ldc + col0;
#pragma unroll
                for (int bj = 0; bj < 2; ++bj) { f32x4 v0 = acc[ai][bj][m][0] + bv[bj][0], v1 = acc[ai][bj][m][1] + bv[bj][1];
                    if (ACT == 1) { f32x2 a = gelu_pk((f32x2){v0[0], v0[1]}), b = gelu_pk((f32x2){v0[2], v0[3]}), c = gelu_pk((f32x2){v1[0], v1[1]}), d = gelu_pk((f32x2){v1[2], v1[3]});
                        v0 = (f32x4){a.x, a.y, b.x, b.y}; v1 = (f32x4){c.x, c.y, d.x, d.y}; }
                    v0 = v0 * sc; v1 = v1 * sc; u32x4 w; w.x = cvt_pk_bf16(v0[0], v0[1]); w.y = cvt_pk_bf16(v0[2], v0[3]); w.z = cvt_pk_bf16(v1[0], v1[1]); w.w = cvt_pk_bf16(v1[2], v1[3]);
                    *(u32x4*)(rowp + bj * HALF) = w; } }
    }
};
struct EpiSwiglu {
    static constexpr bool PERM = true, AFTER_DRAIN = false;
    bf16_t* O; int ldc;
    __device__ __forceinline__ void operator()(const f32x4 (&acc)[2][2][4][2], const Unit& u, int wr, int wc, int fr, int fq) const {
        const int row0 = u.pm * BM + wr * 64 + fr; const int col0 = u.pn * HALF + wc * 32 + 8 * fq;
#pragma unroll
        for (int ai = 0; ai < 2; ++ai)
#pragma unroll
            for (int m = 0; m < 4; ++m) { bf16_t* rowp = O + (size_t)(row0 + ai * HALF + m * 16) * ldc + col0;
                float h[8];
#pragma unroll
                for (int n = 0; n < 2; ++n)
#pragma unroll
                    for (int e = 0; e < 4; ++e) { const float g = acc[ai][0][m][n][e], up = acc[ai][1][m][n][e];
                        h[n * 4 + e] = g * __builtin_amdgcn_rcpf(1.f + __builtin_amdgcn_exp2f(-1.4426950408889634f * g)) * up; }
                u32x4 w; w.x = cvt_pk_bf16(h[0], h[1]); w.y = cvt_pk_bf16(h[2], h[3]); w.z = cvt_pk_bf16(h[4], h[5]); w.w = cvt_pk_bf16(h[6], h[7]);
                *(u32x4*)rowp = w; }
    }
};
struct EpiResid {
    static constexpr bool PERM = false, AFTER_DRAIN = false;
    const float* src_lat; const float* src_ctx; float* dst_lat; float* dst_ctx; const float* gate;
    __device__ __forceinline__ void operator()(const f32x4 (&acc)[2][2][4][2], const Unit& u, int wr, int wc, int fr, int fq) const {
        const int r0 = u.pm * BM; const bool isl = r0 < 32768; const int ci = isl ? (r0 >> 14) : 2;
        const float* sp = isl ? src_lat + (size_t)r0 * 2048 : src_ctx + (size_t)(r0 - 32768) * 2048;
        float* dp = isl ? dst_lat + (size_t)r0 * 2048 : dst_ctx + (size_t)(r0 - 32768) * 2048;
        const float* gp = gate + ci * 12288;
        const int col0 = u.pn * BM + wc * 32 + 4 * fq;
        f32x4 gv[2][2];
#pragma unroll
        for (int bj = 0; bj < 2; ++bj)
#pragma unroll
            for (int n = 0; n < 2; ++n) gv[bj][n] = *(const f32x4*)(gp + col0 + bj * HALF + n * 16);
#pragma unroll
        for (int ai = 0; ai < 2; ++ai)
#pragma unroll
            for (int m = 0; m < 4; ++m) { const size_t off = (size_t)(wr * 64 + ai * HALF + m * 16 + fr) * 2048 + col0;
                f32x4 xv[2][2];
#pragma unroll
                for (int bj = 0; bj < 2; ++bj)
#pragma unroll
                    for (int n = 0; n < 2; ++n) xv[bj][n] = *(const f32x4*)(sp + off + bj * HALF + n * 16);
#pragma unroll
                for (int bj = 0; bj < 2; ++bj)
#pragma unroll
                    for (int n = 0; n < 2; ++n) *(f32x4*)(dp + off + bj * HALF + n * 16) = xv[bj][n] + gv[bj][n] * acc[ai][bj][m][n];
                if (m & 1) asm volatile("" ::: "memory"); }
    }
};

struct CtxSplitOrder {
    int S, klen, G, c;
    __device__ bool next(int i, Unit& u) const { const int L = i * G + c; if (L >= 16 * S) return false; const int t = L / S, kq = L - t * S; u.pm = 128 + (t >> 3); u.pn = t & 7; u.ko = kq * klen; return true; }
    __device__ __forceinline__ void a_ready(const Unit&) const {}
    __device__ __forceinline__ void done(const Unit&) const {}
};
struct EpiPartial {
    static constexpr bool PERM = false, AFTER_DRAIN = false;
    float* part; int klen;
    __device__ __forceinline__ void operator()(const f32x4 (&acc)[2][2][4][2], const Unit& u, int wr, int wc, int fr, int fq) const {
        float* dp = part + ((size_t)(u.ko / klen) * 512 + (size_t)(u.pm - 128) * BM) * 2048;
        const int col0 = u.pn * BM + wc * 32 + 4 * fq;
#pragma unroll
        for (int ai = 0; ai < 2; ++ai)
#pragma unroll
            for (int m = 0; m < 4; ++m) { const size_t off = (size_t)(wr * 64 + ai * HALF + m * 16 + fr) * 2048 + col0;
#pragma unroll
                for (int bj = 0; bj < 2; ++bj)
#pragma unroll
                    for (int n = 0; n < 2; ++n) *(f32x4*)(dp + off + bj * HALF + n * 16) = acc[ai][bj][m][n]; }
    }
};

template <class Epi, class Sched, bool ALIGN_EPI = false, bool SP2 = false>
__device__ __forceinline__ void gemm_phase(PG8_LAS unsigned char* lds, const Gemm g, const Sched& S, const Epi& E) {
    int tid_ = threadIdx.x; asm volatile("" : "+v"(tid_));
    const int tid = tid_, wid = __builtin_amdgcn_readfirstlane(tid >> 6), lane = tid & 63, wr = wid >> 2, wc = wid & 3, fr = lane & 15, fq = lane >> 4;
    const int K = g.ld, nt = g.K / BK;
    unsigned voffA[2], voffB[2];
#pragma unroll
    for (int i = 0; i < 2; ++i) { int R, C; stage_rc(tid * 16 + i * 8192, R, C); const int Rb = Epi::PERM ? ((R & ~31) + perm32(R & 31)) : R;
        voffA[i] = (unsigned)(R * K + C) * 2u; voffB[i] = (unsigned)(Rb * K + C) * 2u; }
    const size_t kstep = (size_t)(BK * 2);
    const size_t hstep = (size_t)HALF * K * 2;
    const size_t tstep = 2 * hstep;
    const unsigned ldsw = (unsigned)wid * 1024u;
    const int aoff = lds_byte(wr * 64 + fr, fq * 8), boff = lds_byte(wc * 32 + fr, fq * 8);
#define PG8_SA(b, h) (((b) * 2 + (h)) * HTB)
#define PG8_SB(b, h) ((4 + (b) * 2 + (h)) * HTB)
#define PG8_STAGE(bufoff, gbase, voff) do { _Pragma("unroll") for (int _i = 0; _i < 2; ++_i) \
        __builtin_amdgcn_global_load_lds((const unsigned*)((const char*)(gbase) + (voff)[_i]), (PG8_LAS unsigned*)(lds + (bufoff) + ldsw + _i * 8192), 16, 0, 0); } while (0)
#define PG8_LDA(dst, b, h) do { _Pragma("unroll") for (int m = 0; m < 4; ++m) _Pragma("unroll") for (int k = 0; k < 2; ++k) dst[m][k] = *(const PG8_LAS bf16x8*)(lds + PG8_SA(b, h) + aoff + m * 2048 + k * 1024); } while (0)
#define PG8_LDB(dst, b, h) do { _Pragma("unroll") for (int n = 0; n < 2; ++n) _Pragma("unroll") for (int k = 0; k < 2; ++k) dst[n][k] = *(const PG8_LAS bf16x8*)(lds + PG8_SB(b, h) + boff + n * 2048 + k * 1024); } while (0)
#define PG8_MMA(ai, bj, At, Bt) do { __builtin_amdgcn_s_setprio(1); _Pragma("unroll") for (int m = 0; m < 4; ++m) _Pragma("unroll") for (int n = 0; n < 2; ++n) _Pragma("unroll") for (int k = 0; k < 2; ++k) \
        acc[ai][bj][m][n] = __builtin_amdgcn_mfma_f32_16x16x32_bf16(Bt[n][k], At[m][k], acc[ai][bj][m][n], 0, 0, 0); __builtin_amdgcn_s_setprio(0); } while (0)
#define PG8_WAIT_V(n) asm volatile("s_waitcnt vmcnt(" #n ")" ::: "memory")
#define PG8_WAIT_L(n) asm volatile("s_waitcnt lgkmcnt(" #n ")" ::: "memory")
#define PG8_BAR __builtin_amdgcn_s_barrier()
#define PG8_SCHED __builtin_amdgcn_sched_barrier(0)
    Unit cur, nxt; int ui = 0;
    if (!S.next(0, cur)) return;
    f32x4 acc[2][2][4][2];
#pragma unroll
    for (int a = 0; a < 2; ++a)
#pragma unroll
        for (int b = 0; b < 2; ++b)
#pragma unroll
            for (int m = 0; m < 4; ++m)
#pragma unroll
                for (int n = 0; n < 2; ++n) acc[a][b][m][n] = (f32x4){0.f, 0.f, 0.f, 0.f};
    bf16x8 At[4][2], B0[2][2], B1[2][2];
    const char* cA = (const char*)g.A + (size_t)cur.pm * tstep + (size_t)cur.ko * 2; const char* cB = (const char*)g.Bt + (size_t)cur.pn * tstep + (size_t)cur.ko * 2;
    S.a_ready(cur);
    if constexpr (SP2) {
        PG8_STAGE(PG8_SB(0, 0), cB, voffB); PG8_STAGE(PG8_SB(0, 1), cB + hstep, voffB); PG8_STAGE(PG8_SA(0, 0), cA, voffA); PG8_STAGE(PG8_SA(0, 1), cA + hstep, voffA);
        if (wr == 1) PG8_BAR;
        PG8_WAIT_V(2); PG8_BAR;
        PG8_STAGE(PG8_SB(1, 0), cB + kstep, voffB); PG8_STAGE(PG8_SA(1, 0), cA + kstep, voffA); PG8_STAGE(PG8_SB(1, 1), cB + hstep + kstep, voffB);
        PG8_WAIT_V(6); PG8_BAR;
    } else {
        PG8_STAGE(PG8_SB(0, 0), cB, voffB); PG8_STAGE(PG8_SA(0, 0), cA, voffA); PG8_STAGE(PG8_SB(0, 1), cB + hstep, voffB); PG8_STAGE(PG8_SA(0, 1), cA + hstep, voffA);
        if (wr == 1) PG8_BAR;
        PG8_WAIT_V(4); PG8_BAR;
        PG8_STAGE(PG8_SB(1, 0), cB + kstep, voffB); PG8_STAGE(PG8_SA(1, 0), cA + kstep, voffA); PG8_STAGE(PG8_SB(1, 1), cB + hstep + kstep, voffB);
        PG8_WAIT_V(6); PG8_BAR;
    }
    for (;;) {
        const bool has_next = S.next(ui + 1, nxt);
        const char* nA = has_next ? (const char*)g.A + (size_t)nxt.pm * tstep + (size_t)nxt.ko * 2 : cA; const char* nB = has_next ? (const char*)g.Bt + (size_t)nxt.pn * tstep + (size_t)nxt.ko * 2 : cB;
        for (int t = 0; t < nt; t += 2) {
            const bool last = (t == nt - 2);
            const char* a1 = cA + (size_t)(t + 1) * kstep;
            const char* a2 = last ? nA : cA + (size_t)(t + 2) * kstep; const char* b2 = last ? nB : cB + (size_t)(t + 2) * kstep;
            const char* a3 = a2 + kstep; const char* b3 = b2 + kstep;
            if (last && has_next) S.a_ready(nxt);
            if constexpr (SP2) {
            PG8_LDB(B0, 0, 0); PG8_LDB(B1, 0, 1); PG8_SCHED; PG8_LDA(At, 0, 0); PG8_STAGE(PG8_SA(1, 1), a1 + hstep, voffA);
            PG8_WAIT_V(8); PG8_WAIT_L(0); PG8_BAR; PG8_MMA(0, 0, At, B0); PG8_MMA(0, 1, At, B1); PG8_BAR; PG8_SCHED;
            PG8_LDA(At, 0, 1); PG8_STAGE(PG8_SB(0, 0), b2, voffB); PG8_STAGE(PG8_SB(0, 1), b2 + hstep, voffB); PG8_STAGE(PG8_SA(0, 0), a2, voffA);
            PG8_WAIT_V(8); PG8_WAIT_L(0); PG8_BAR; PG8_MMA(1, 0, At, B0); PG8_MMA(1, 1, At, B1); PG8_BAR; PG8_SCHED;
            PG8_LDB(B0, 1, 0); PG8_LDB(B1, 1, 1); PG8_SCHED; PG8_LDA(At, 1, 0); PG8_STAGE(PG8_SA(0, 1), a2 + hstep, voffA);
            PG8_WAIT_V(8); PG8_WAIT_L(0); PG8_BAR; PG8_MMA(0, 0, At, B0); PG8_MMA(0, 1, At, B1); PG8_BAR; PG8_SCHED;
            PG8_LDA(At, 1, 1); PG8_STAGE(PG8_SB(1, 0), b3, voffB); PG8_STAGE(PG8_SB(1, 1), b3 + hstep, voffB); PG8_STAGE(PG8_SA(1, 0), a3, voffA);
            PG8_WAIT_V(8); PG8_WAIT_L(0); PG8_BAR; PG8_MMA(1, 0, At, B0); PG8_MMA(1, 1, At, B1); PG8_BAR; PG8_SCHED;
            } else {
            PG8_LDB(B0, 0, 0); PG8_SCHED; PG8_LDA(At, 0, 0); PG8_STAGE(PG8_SA(1, 1), a1 + hstep, voffA);
            PG8_WAIT_L(8); PG8_BAR; PG8_WAIT_L(0); PG8_MMA(0, 0, At, B0); PG8_BAR; PG8_SCHED;
            PG8_LDB(B1, 0, 1); PG8_STAGE(PG8_SB(0, 0), b2, voffB);
            PG8_BAR; PG8_WAIT_L(0); PG8_MMA(0, 1, At, B1); PG8_BAR;
            PG8_LDA(At, 0, 1); PG8_STAGE(PG8_SA(0, 0), a2, voffA);
            PG8_BAR; PG8_WAIT_L(0); PG8_MMA(1, 0, At, B0); PG8_BAR; PG8_SCHED;
            PG8_STAGE(PG8_SB(0, 1), b2 + hstep, voffB);
            PG8_WAIT_V(6); PG8_BAR; PG8_MMA(1, 1, At, B1); PG8_BAR;
            PG8_LDB(B0, 1, 0); PG8_SCHED; PG8_LDA(At, 1, 0); PG8_STAGE(PG8_SA(0, 1), a2 + hstep, voffA);
            PG8_WAIT_L(8); PG8_BAR; PG8_WAIT_L(0); PG8_MMA(0, 0, At, B0); PG8_BAR; PG8_SCHED;
            PG8_LDB(B1, 1, 1); PG8_STAGE(PG8_SB(1, 0), b3, voffB);
            PG8_BAR; PG8_WAIT_L(0); PG8_MMA(0, 1, At, B1); PG8_BAR;
            PG8_LDA(At, 1, 1); PG8_STAGE(PG8_SA(1, 0), a3, voffA);
            PG8_BAR; PG8_WAIT_L(0); PG8_MMA(1, 0, At, B0); PG8_BAR; PG8_SCHED;
            PG8_STAGE(PG8_SB(1, 1), b3 + hstep, voffB);
            PG8_WAIT_V(6); PG8_BAR; PG8_MMA(1, 1, At, B1); PG8_BAR;
            }
        }
        if constexpr (ALIGN_EPI) { if (wr == 0) PG8_BAR; }
        if constexpr (!Epi::AFTER_DRAIN) { E(acc, cur, wr, wc, fr, fq); S.done(cur); }
        if (!has_next) break;
#pragma unroll
        for (int a = 0; a < 2; ++a)
#pragma unroll
            for (int b = 0; b < 2; ++b)
#pragma unroll
                for (int m = 0; m < 4; ++m)
#pragma unroll
                    for (int n = 0; n < 2; ++n) acc[a][b][m][n] = (f32x4){0.f, 0.f, 0.f, 0.f};
        cur = nxt; cA = nA; cB = nB; ++ui;
        if constexpr (ALIGN_EPI) { if (wr == 1) PG8_BAR; }
    }
    PG8_WAIT_V(0);
    if constexpr (!ALIGN_EPI) { if (wr == 0) PG8_BAR; }
    PG8_BAR;
    if constexpr (Epi::AFTER_DRAIN) { E.fused(acc, cur, wr, wc, fr, fq, lds, wid, lane); S.done(cur); }
#undef PG8_SA
#undef PG8_SB
#undef PG8_STAGE
#undef PG8_LDA
#undef PG8_LDB
#undef PG8_MMA
#undef PG8_WAIT_V
#undef PG8_WAIT_L
#undef PG8_BAR
#undef PG8_SCHED
}
}
#define LAS __attribute__((address_space(3)))
#define GAS __attribute__((address_space(1)))
typedef unsigned short bf16;
typedef short bf16x8 __attribute__((ext_vector_type(8)));
typedef float f32x4 __attribute__((ext_vector_type(4)));
typedef float f32x2 __attribute__((ext_vector_type(2)));
typedef unsigned u32x4 __attribute__((ext_vector_type(4)));
typedef unsigned u32x2 __attribute__((ext_vector_type(2)));
typedef __bf16 bf16x2_t __attribute__((ext_vector_type(2)));

constexpr int NWAVES = 8, NTHR = 512;
constexpr int DM = 2048, NBATCH = 2, SEQ = 16384, CTXL = 256, MLAT = NBATCH * SEQ, MCTX = NBATCH * CTXL, MROWS = MLAT + MCTX;
constexpr int FFH = 5632;
constexpr float EPS = 1e-6f;
constexpr float LOG2E = 1.4426950408889634f;
constexpr size_t MiB = 1u << 20;
enum { I_X = 0, I_C, I_CTX, I_CCTX, I_MODW, I_MODB, I_NORMG, I_FFNWI, I_FFNWO, I_RGWI, I_RGCW, I_RGCB, I_RGGW, I_RGGB, I_RGLAM, I_RGWO,
       I_HGWI, I_HGLB, I_HGGN, I_HGWO, I_MLWI, I_MLQN, I_MLKVN, I_MLUQ, I_MLUKV, I_MLQKG, I_MLWO, I_SWWI, I_SWQKG, I_SWSINK, I_SWWO, N_IN };
constexpr size_t WS_CTL = 0, CTL_ZERO_BYTES = 64 * 1024;
constexpr size_t WS_MODV = 1 * MiB;
constexpr size_t WS_TAB = 2 * MiB;
constexpr size_t WS_XC = 4 * MiB;
constexpr size_t WS_W = 8 * MiB;
constexpr size_t W_RGWI = WS_W, W_RGG = W_RGWI + 16 * MiB, W_RGWO = W_RGG + 2 * MiB, W_HGWI = W_RGWO + 8 * MiB, W_HGWO = W_HGWI + 40 * MiB,
                 W_MLWI = W_HGWO + 8 * MiB, W_MLUQ = W_MLWI + 5 * MiB, W_MLUKV = W_MLUQ + 3 * MiB, W_MLWO = W_MLUKV + 4 * MiB,
                 W_SWWI = W_MLWO + 8 * MiB, W_SWWO = W_SWWI + 12 * MiB, W_FUP = W_SWWO + 8 * MiB, W_FDN = W_FUP + 44 * MiB, W_END = W_FDN + 22 * MiB;
static_assert(W_END == 188 * MiB, "weights map");
constexpr size_t WS_H = 188 * MiB;
constexpr size_t WS_BIG = 318 * MiB;
static_assert(WS_H + (size_t)MROWS * DM * 2 <= WS_BIG, "H");
constexpr size_t B_HID = WS_BIG;
constexpr size_t B_GR = WS_BIG;
constexpr size_t B_CARRY = WS_BIG + 264 * MiB;
constexpr size_t B_HIN = B_CARRY + 20 * MiB;
constexpr size_t SEC = (size_t)MROWS * DM * 2;
constexpr size_t B_HG = WS_BIG;
constexpr size_t B_ST = WS_BIG + 5 * SEC;
constexpr size_t B_DV = B_ST + (size_t)4160 * 65536;
constexpr size_t B_OF = B_DV + 4 * MiB;
constexpr size_t B_OB = B_OF + SEC;
constexpr size_t B_MLC = WS_BIG;
constexpr size_t B_CQN = B_MLC + 82 * MiB;
constexpr size_t B_CKVN = B_CQN + 33 * MiB;
constexpr size_t B_KR = B_CKVN + 33 * MiB;
constexpr size_t B_Q = B_KR + 5 * MiB;
constexpr size_t B_KV = B_Q + 196 * MiB;
constexpr size_t B_KN = B_KV + 261 * MiB;
constexpr size_t B_QKV = WS_BIG;
constexpr size_t B_PART = WS_BIG + 1170 * MiB;
constexpr size_t WS_END = (size_t)1536 * MiB;
static_assert(B_OB + SEC <= WS_END && B_KN + 196 * MiB <= WS_END && B_HID + (size_t)MROWS * FFH * 2 <= WS_END, "workspace map");
constexpr int T_MC_R = 0, T_MS_R = T_MC_R + 256 * 16, T_MC_C = T_MS_R + 256 * 16, T_MS_C = T_MC_C + 64 * 16,
              T_SC_R = T_MS_C + 64 * 16, T_SS_R = T_SC_R + 256 * 32, T_SC_C = T_SS_R + 256 * 32, T_SS_C = T_SC_C + 64 * 32,
              T_LB = T_SS_C + 64 * 32, T_MFIX = T_LB + 2 * 2048, T_END = T_MFIX + 4;
constexpr int CW_BAR = 1024;
constexpr int RING_BYTES = 139264, MISC_OFF = RING_BYTES, LDS_BYTES = 147456;

#define LDS_WAIT() asm volatile("s_waitcnt lgkmcnt(0)" ::: "memory")
#define VM_WAIT() asm volatile("s_waitcnt vmcnt(0)" ::: "memory")
__device__ __forceinline__ float bf2f(unsigned short h) { return __uint_as_float((unsigned)h << 16); }
__device__ __forceinline__ float bflo(unsigned w) { return __uint_as_float(w << 16); }
__device__ __forceinline__ float bfhi(unsigned w) { return __uint_as_float(w & 0xffff0000u); }
__device__ __forceinline__ unsigned pk2(float lo, float hi) { f32x2 v = {lo, hi}; bf16x2_t b = __builtin_convertvector(v, bf16x2_t); return __builtin_bit_cast(unsigned, b); }
__device__ __forceinline__ unsigned short f2bf(float f) { return (unsigned short)(pk2(f, 0.f) & 0xffffu); }
__device__ __forceinline__ float fexp(float x) { return __builtin_amdgcn_exp2f(x * LOG2E); }
__device__ __forceinline__ float flog(float x) { return __builtin_amdgcn_logf(x) * 0.6931471805599453f; }
__device__ __forceinline__ float frcp(float x) { return __builtin_amdgcn_rcpf(x); }
__device__ __forceinline__ float sigm(float x) { return frcp(1.f + fexp(-x)); }
__device__ __forceinline__ float silu(float x) { return x * sigm(x); }
__device__ __forceinline__ float frsq(float x) { return __builtin_amdgcn_rsqf(x); }
__device__ __forceinline__ float wave_sum(float v) {
#pragma unroll
    for (int o = 1; o < 64; o <<= 1) v += __shfl_xor(v, o);
    return v;
}
__device__ __forceinline__ float quad_sum(float v) { v += __shfl_xor(v, 1); v += __shfl_xor(v, 2); return v; }
__device__ __forceinline__ void unpack8(const u32x4 w, float (&f)[8]) {
    f[0] = bflo(w.x); f[1] = bfhi(w.x); f[2] = bflo(w.y); f[3] = bfhi(w.y); f[4] = bflo(w.z); f[5] = bfhi(w.z); f[6] = bflo(w.w); f[7] = bfhi(w.w);
}
__device__ __forceinline__ u32x4 pack8(const float (&f)[8]) { u32x4 w; w.x = pk2(f[0], f[1]); w.y = pk2(f[2], f[3]); w.z = pk2(f[4], f[5]); w.w = pk2(f[6], f[7]); return w; }

__device__ __forceinline__ void cvt_item(const float* W, int ldw, bf16* dst, int ldd, LAS float* scr, int lane) {
#pragma unroll 8
    for (int i = 0; i < 32; ++i) { const int kk = 2 * i + (lane >> 5); scr[kk * 33 + (lane & 31)] = W[(size_t)kk * ldw + (lane & 31)]; }
    LDS_WAIT(); asm volatile("" ::: "memory");
    const int c = lane & 7;
#pragma unroll
    for (int j = 0; j < 4; ++j) { const int n = (lane >> 3) + 8 * j; const LAS float* s = scr + (8 * c) * 33 + n;
        u32x4 o; o.x = pk2(s[0 * 33], s[1 * 33]); o.y = pk2(s[2 * 33], s[3 * 33]); o.z = pk2(s[4 * 33], s[5 * 33]); o.w = pk2(s[6 * 33], s[7 * 33]);
        *(GAS u32x4*)(dst + (size_t)n * ldd + 8 * c) = o; }
    LDS_WAIT(); asm volatile("" ::: "memory");
}
template <int MAP> __device__ __forceinline__ void cvt_matrix(const float* W, int K, int N, bf16* D, LAS float* scr, int gw, int NGW, int lane) {
    const int nblk = N / 32, items = (K / 64) * nblk;
    for (int it = gw; it < items; it += NGW) {
        const int kb = it / nblk, nb = it - kb * nblk, n0 = 32 * nb, k0 = 64 * kb;
        int drow = n0;
        if (MAP == 1) { const int up = n0 >= FFH; const int nn = up ? n0 - FFH : n0; drow = 256 * (nn >> 7) + (up ? 128 : 0) + (nn & 127); }
        cvt_item(W + (size_t)k0 * N + n0, N, D + (size_t)drow * K + k0, K, scr, lane);
    }
}
__device__ __forceinline__ void cvt_ffn(const float* wi, const float* wo, int layer, unsigned char* ws, LAS float* scr, int gw, int NGW, int lane) {
    cvt_matrix<1>(wi + (size_t)layer * DM * 2 * FFH, DM, 2 * FFH, (bf16*)(ws + W_FUP), scr, gw, NGW, lane);
    cvt_matrix<0>(wo + (size_t)layer * FFH * DM, FFH, DM, (bf16*)(ws + W_FDN), scr, gw, NGW, lane);
}
__device__ __forceinline__ void sincos_d(float a, float& s, float& c) {
    const double TWO_PI = 6.283185307179586476925286766559, INV_2PI = 0.15915494309189533576888376337251;
    double t = (double)a * INV_2PI; t -= __builtin_rint(t); const double r = t * TWO_PI, r2 = r * r;
    double ts = r, ss = r, tc = 1.0, cc = 1.0;
    for (int n = 1; n <= 15; ++n) { ts *= -r2 / (double)((2 * n) * (2 * n + 1)); ss += ts; tc *= -r2 / (double)((2 * n - 1) * (2 * n)); cc += tc; }
    s = (float)ss; c = (float)cc;
}
__device__ __forceinline__ void prologue(const float* const* in, unsigned char* ws, LAS unsigned char* lds, int bid, int G, int tid) {
    const int lane = tid & 63, wave = tid >> 6, gw = bid * NWAVES + wave, NGW = G * NWAVES, gt = bid * NTHR + tid, NGT = G * NTHR;
    LAS float* scr = (LAS float*)(lds + wave * 16384);
    cvt_matrix<0>(in[I_RGWI], DM, 4096, (bf16*)(ws + W_RGWI), scr, gw, NGW, lane);
    for (int it = gw; it < 512; it += NGW) {
        const int mtx = it >> 3, sub = it & 7, dg = mtx >> 4, k = mtx & 15, kb = sub >> 2, nb = sub & 3;
        const float* W = in[I_RGGW] + (size_t)mtx * 16384; bf16* D = (bf16*)(ws + W_RGG) + ((size_t)k * 512 + dg * 128) * 128;
        cvt_item(W + (size_t)(64 * kb) * 128 + 32 * nb, 128, D + (size_t)(32 * nb) * 128 + 64 * kb, 128, scr, lane);
    }
    cvt_matrix<0>(in[I_RGWO], DM, DM, (bf16*)(ws + W_RGWO), scr, gw, NGW, lane);
    cvt_matrix<0>(in[I_HGWI], DM, 10240, (bf16*)(ws + W_HGWI), scr, gw, NGW, lane);
    cvt_matrix<0>(in[I_HGWO], DM, DM, (bf16*)(ws + W_HGWO), scr, gw, NGW, lane);
    cvt_matrix<0>(in[I_MLWI], DM, 1088, (bf16*)(ws + W_MLWI), scr, gw, NGW, lane);
    for (int i = gt; i < 192 * DM / 8; i += NGT) ((GAS u32x4*)((bf16*)(ws + W_MLWI) + (size_t)1088 * DM))[i] = (u32x4){0u, 0u, 0u, 0u};
    cvt_matrix<0>(in[I_MLUQ], 512, 3072, (bf16*)(ws + W_MLUQ), scr, gw, NGW, lane);
    cvt_matrix<0>(in[I_MLUKV], 512, 4096, (bf16*)(ws + W_MLUKV), scr, gw, NGW, lane);
    cvt_matrix<0>(in[I_MLWO], DM, DM, (bf16*)(ws + W_MLWO), scr, gw, NGW, lane);
    cvt_matrix<0>(in[I_SWWI], DM, 3072, (bf16*)(ws + W_SWWI), scr, gw, NGW, lane);
    cvt_matrix<0>(in[I_SWWO], DM, DM, (bf16*)(ws + W_SWWO), scr, gw, NGW, lane);
    cvt_ffn(in[I_FFNWI], in[I_FFNWO], 0, ws, scr, gw, NGW, lane);
    float* tab = (float*)(ws + WS_TAB);
    for (int i = gt; i < 320 * 16 + 320 * 32; i += NGT) {
        int nf, j, pos, isc; float* cdst; float* sdst;
        if (i < 320 * 16) { nf = 16; const int p = i >> 4; j = i & 15; isc = p >= 256; pos = isc ? p - 256 : p; cdst = tab + (isc ? T_MC_C : T_MC_R) + pos * 16 + j; sdst = tab + (isc ? T_MS_C : T_MS_R) + pos * 16 + j; }
        else { const int i2 = i - 320 * 16; nf = 32; const int p = i2 >> 5; j = i2 & 31; isc = p >= 256; pos = isc ? p - 256 : p; cdst = tab + (isc ? T_SC_C : T_SC_R) + pos * 32 + j; sdst = tab + (isc ? T_SS_C : T_SS_R) + pos * 32 + j; }
        const float inv = exp2f(-((float)j / (float)nf) * 13.287712379549449f);
        const float ang = (float)pos * inv; float s, c; sincos_d(ang, s, c); *cdst = c; *sdst = s;
    }
    for (int i = gt; i < 2 * 2048; i += NGT) {
        const float* lg = in[I_HGLB]; const float a0 = lg[i], a1 = lg[4096 + i], a2 = lg[8192 + i], a3 = lg[12288 + i];
        const float mx = fmaxf(fmaxf(a0, a1), fmaxf(a2, a3)); const float e0 = expf(a0 - mx), e1 = expf(a1 - mx), e2 = expf(a2 - mx), e3 = expf(a3 - mx);
        tab[T_LB + i] = e1 / (e0 + e1 + e2 + e3);
    }
    if (gw == 0) {
        const float* g = in[I_MLQKG];
        const float q0 = g[lane], q1 = g[64 + lane], q2 = g[128 + lane], k0 = g[192 + lane], k1 = g[256 + lane], k2 = g[320 + lane];
        float a0 = fmaxf(q0 * q0, q1 * q1), a1 = q2 * q2, b0 = fmaxf(k0 * k0, k1 * k1), b1 = k2 * k2;
#pragma unroll
        for (int m = 1; m < 64; m <<= 1) { a0 = fmaxf(a0, __shfl_xor(a0, m)); a1 = fmaxf(a1, __shfl_xor(a1, m)); b0 = fmaxf(b0, __shfl_xor(b0, m)); b1 = fmaxf(b1, __shfl_xor(b1, m)); }
        const float bound = sqrtf((128.f * a0 + 64.f * a1) * (128.f * b0 + 64.f * b1)) * 0.07216878364870322f * LOG2E;
        if (lane == 0) tab[T_MFIX] = (bound > 0.f && bound < 60.f) ? bound : 0.f;
    }
    __syncthreads();
    LAS float* cond = (LAS float*)lds; LAS float* part = (LAS float*)(lds + 32768);
    for (int i = tid; i < 3 * DM; i += NTHR) { const float v = i < 2 * DM ? in[I_C][i] : in[I_CCTX][i - 2 * DM]; cond[i] = v / (1.f + expf(-v)); }
    __syncthreads();
    float* modv = (float*)(ws + WS_MODV);
    for (int it = bid; it < 4 * 192; it += G) {
        const int l = it / 192, n0 = (it - l * 192) * 64; const int kq = lane >> 4, c4 = lane & 15;
        f32x4 acc[3] = {{0.f, 0.f, 0.f, 0.f}, {0.f, 0.f, 0.f, 0.f}, {0.f, 0.f, 0.f, 0.f}};
        const float* wp = in[I_MODW] + ((size_t)l * DM + 256 * wave + kq) * 12288 + n0 + 4 * c4;
#pragma unroll 16
        for (int i = 0; i < 64; ++i) { const f32x4 wv = *(const f32x4*)(wp + (size_t)(4 * i) * 12288); const int k = 256 * wave + 4 * i + kq;
            acc[0] += cond[k] * wv; acc[1] += cond[DM + k] * wv; acc[2] += cond[2 * DM + k] * wv; }
#pragma unroll
        for (int ci = 0; ci < 3; ++ci)
#pragma unroll
            for (int e = 0; e < 4; ++e) { float v = acc[ci][e]; v += __shfl_xor(v, 16); v += __shfl_xor(v, 32); acc[ci][e] = v; }
        if (kq == 0) {
#pragma unroll
            for (int ci = 0; ci < 3; ++ci)
#pragma unroll
                for (int e = 0; e < 4; ++e) part[(wave * 3 + ci) * 64 + 4 * c4 + e] = acc[ci][e]; }
        __syncthreads();
        if (tid < 192) { const int ci = tid >> 6, cc = tid & 63; float s = in[I_MODB][l * 12288 + n0 + cc];
#pragma unroll
            for (int w = 0; w < 8; ++w) s += part[(w * 3 + ci) * 64 + cc];
            modv[(size_t)(l * 3 + ci) * 12288 + n0 + cc] = s; }
        __syncthreads();
    }
}

__device__ __forceinline__ void norm_phase(const float* xlat, const float* xctx, const float* g, const float* modv_l, int which, bf16* H, int mrows, int gw, int NGW, int lane,
                                           const float* part, int nsplit, const float* pgate, float* xctx_out) {
    for (int m = mrows - 1 - gw; m >= 0; m -= NGW) {
        const bool isl = m < MLAT; const int ci = isl ? (m >> 14) : 2;
        const float* xr = isl ? xlat + (size_t)m * DM : xctx + (size_t)(m - MLAT) * DM;
        const float* sh = modv_l + ci * 12288 + (which ? 3 : 0) * DM; const float* sc = sh + DM;
        f32x4 v[8]; float s = 0.f;
#pragma unroll
        for (int j = 0; j < 8; ++j) v[j] = ((const f32x4*)xr)[lane + 64 * j];
        if (!isl && part) {
#pragma unroll
            for (int j = 0; j < 8; ++j) { f32x4 a = {0.f, 0.f, 0.f, 0.f};
                for (int q = 0; q < nsplit; ++q) a += ((const f32x4*)(part + ((size_t)q * 512 + (m - MLAT)) * DM))[lane + 64 * j];
                v[j] += ((const f32x4*)pgate)[lane + 64 * j] * a; ((f32x4*)(xctx_out + (size_t)(m - MLAT) * DM))[lane + 64 * j] = v[j]; }
        }
#pragma unroll
        for (int j = 0; j < 8; ++j) s += (v[j].x * v[j].x + v[j].y * v[j].y) + (v[j].z * v[j].z + v[j].w * v[j].w);
        s = wave_sum(s); const float rstd = frsq(s * (1.f / DM) + EPS);
#pragma unroll
        for (int j = 0; j < 8; ++j) { const int c4 = lane + 64 * j; const f32x4 gg = ((const f32x4*)g)[c4], ss = ((const f32x4*)sc)[c4], hh = ((const f32x4*)sh)[c4];
            const f32x4 o = (v[j] * rstd) * gg * (1.f + ss) + hh; u32x2 w; w.x = pk2(o.x, o.y); w.y = pk2(o.z, o.w); ((u32x2*)(H + (size_t)m * DM))[c4] = w; }
    }
}
__device__ __forceinline__ void mla_prep1(const bf16* C, const float* qng, const float* kvng, const float* qkg, const float* tab, bf16* CQN, bf16* CKVN, bf16* KR, int gw, int NGW, int lane) {
    float g1[8], g2[8];
#pragma unroll
    for (int e = 0; e < 8; ++e) { g1[e] = qng[8 * lane + e]; g2[e] = kvng[8 * lane + e]; }
    const float gk = qkg[192 + 128 + lane];
    for (int m0 = gw; m0 < MROWS; m0 += 2 * NGW) {
        const int m1 = m0 + NGW; const bool two = m1 < MROWS;
        u32x4 a[2], b[2]; float kr[2];
#pragma unroll
        for (int r = 0; r < 2; ++r) { const bf16* cr = C + (size_t)(r == 0 || two ? (r == 0 ? m0 : m1) : m0) * 1280;
            a[r] = *(const u32x4*)(cr + 8 * lane); b[r] = *(const u32x4*)(cr + 512 + 8 * lane); kr[r] = bf2f(cr[1024 + lane]); }
#pragma unroll
        for (int r = 0; r < 2; ++r) { if (r == 1 && !two) break; const int m = r == 0 ? m0 : m1;
            float fa[8], fb[8]; unpack8(a[r], fa); unpack8(b[r], fb); float sa = 0.f, sb = 0.f;
#pragma unroll
            for (int e = 0; e < 8; ++e) { sa += fa[e] * fa[e]; sb += fb[e] * fb[e]; }
            sa = wave_sum(sa); sb = wave_sum(sb); const float sk = wave_sum(kr[r] * kr[r]);
            const float ra = frsq(sa * (1.f / 512.f) + EPS), rb = frsq(sb * (1.f / 512.f) + EPS), rk = frsq(sk * (1.f / 64.f) + EPS);
#pragma unroll
            for (int e = 0; e < 8; ++e) { fa[e] = fa[e] * ra * g1[e]; fb[e] = fb[e] * rb * g2[e]; }
            *(u32x4*)(CQN + (size_t)m * 512 + 8 * lane) = pack8(fa); *(u32x4*)(CKVN + (size_t)m * 512 + 8 * lane) = pack8(fb);
            float y = kr[r] * rk * gk; const float py = __shfl_xor(y, 16);
            if (m < MLAT) { const int t = m & (SEQ - 1), j = lane & 15; const bool isr = lane < 32; const int pos = isr ? (t >> 6) : (t & 63);
                const float cs = tab[(isr ? T_MC_R : T_MC_C) + pos * 16 + j], sn = tab[(isr ? T_MS_R : T_MS_C) + pos * 16 + j];
                y = ((lane >> 4) & 1) ? py * sn + y * cs : y * cs - py * sn; }
            KR[(size_t)m * 64 + lane] = f2bf(y); }
    }
}
__device__ __forceinline__ void mla_prep2(bf16* Q, const bf16* KV, const bf16* KR, bf16* KN, const float* qkg, const float* tab, int gw, int NGW, int lane, const float qscale) {
    const int h = lane >> 2, s = lane & 3;
    float gkn[32];
#pragma unroll
    for (int i = 0; i < 32; ++i) gkn[i] = qkg[192 + 32 * s + i];
    for (int m = gw; m < MROWS; m += NGW) {
        float x[32];
        const bf16* kp = KV + (size_t)m * 4096 + h * 256 + 32 * s; bf16* kn = KN + (size_t)m * 3072 + h * 192; float sk = 0.f;
#pragma unroll
        for (int v = 0; v < 4; ++v) { float f[8]; unpack8(*(const u32x4*)(kp + 8 * v), f);
#pragma unroll
            for (int e = 0; e < 8; ++e) { x[8 * v + e] = f[e]; sk += f[e] * f[e]; } }
        sk = quad_sum(sk); const float rk = frsq(sk * (1.f / 128.f) + EPS);
#pragma unroll
        for (int v = 0; v < 4; ++v) { float f[8];
#pragma unroll
            for (int e = 0; e < 8; ++e) f[e] = x[8 * v + e] * rk * gkn[8 * v + e];
            *(u32x4*)(kn + 32 * s + 8 * v) = pack8(f); }
        const u32x4 k0 = *(const u32x4*)(KR + (size_t)m * 64 + 16 * s), k1 = *(const u32x4*)(KR + (size_t)m * 64 + 16 * s + 8);
        *(u32x4*)(kn + 128 + 16 * s) = k0; *(u32x4*)(kn + 128 + 16 * s + 8) = k1;
    }
}
__device__ __forceinline__ void swa_norm_rope(bf16* p, const float (&g)[32], bool isl, int t, int s, const float* tab, bool store) {
    float x[32]; float ss = 0.f;
#pragma unroll
    for (int v = 0; v < 4; ++v) { float f[8]; unpack8(*(const u32x4*)(p + 8 * v), f);
#pragma unroll
        for (int e = 0; e < 8; ++e) { x[8 * v + e] = f[e]; ss += f[e] * f[e]; } }
    const int pos = (s < 2) ? (t >> 6) : (t & 63); const float* tc = tab + ((s < 2) ? T_SC_R : T_SC_C) + pos * 32; const float* ts = tab + ((s < 2) ? T_SS_R : T_SS_C) + pos * 32;
    f32x4 cv[8], sv[8];
#pragma unroll
    for (int v = 0; v < 8; ++v) { cv[v] = ((const f32x4*)tc)[v]; sv[v] = ((const f32x4*)ts)[v]; }
    ss = quad_sum(ss); const float rn = frsq(ss * (1.f / 128.f) + EPS);
#pragma unroll
    for (int v = 0; v < 4; ++v) { float f[8];
#pragma unroll
        for (int e = 0; e < 8; ++e) { const int j = 8 * v + e; float y = x[j] * rn * g[j]; const float py = __shfl_xor(y, 1);
            const float cs = isl ? cv[j >> 2][j & 3] : 1.f, sn = isl ? sv[j >> 2][j & 3] : 0.f;
            y = (s & 1) ? py * sn + y * cs : y * cs - py * sn;
            f[e] = y; }
        if (store) *(u32x4*)(p + 8 * v) = pack8(f); }
}
__device__ __forceinline__ void swa_prep(bf16* QKV, const float* qkg, const float* tab, int gw, int NGW, int lane) {
    const int h = (lane >> 2) & 3, s = lane & 3;
    float gk[32];
#pragma unroll
    for (int i = 0; i < 32; ++i) gk[i] = qkg[128 + 32 * s + i];
    for (int m = 4 * gw + (lane >> 4); m < MROWS; m += 4 * NGW) {
        const bool isl = m < MLAT; const int t = m & (SEQ - 1);
        swa_norm_rope(QKV + (size_t)m * 3072 + 2048 + h * 128 + 32 * s, gk, isl, t, s, tab, true);
    }
}
__device__ __forceinline__ void gla_final(const bf16* OF, const bf16* OB, const bf16* Gs, const float* gn, bf16* Y, int gw, int NGW, int lane) {
    const int h = lane >> 2, s = lane & 3;
    float gng[32];
#pragma unroll
    for (int i = 0; i < 32; ++i) gng[i] = gn[32 * s + i];
    for (int m = gw; m < MROWS; m += NGW) {
        const size_t off = (size_t)m * DM + h * 128 + 32 * s; float x[32]; float ss = 0.f;
#pragma unroll
        for (int v = 0; v < 4; ++v) { float a[8], b[8]; unpack8(*(const u32x4*)(OF + off + 8 * v), a); unpack8(*(const u32x4*)(OB + off + 8 * v), b);
#pragma unroll
            for (int e = 0; e < 8; ++e) { const float o = a[e] + b[e]; x[8 * v + e] = o; ss += o * o; } }
        ss = quad_sum(ss); const float rn = frsq(ss * (1.f / 128.f) + EPS);
#pragma unroll
        for (int v = 0; v < 4; ++v) { float gg[8], f[8]; unpack8(*(const u32x4*)(Gs + off + 8 * v), gg);
#pragma unroll
            for (int e = 0; e < 8; ++e) f[e] = x[8 * v + e] * rn * gng[8 * v + e] * silu(gg[e]);
            *(u32x4*)(Y + off + 8 * v) = pack8(f); }
    }
}
#define XB_TMO      128
#define XB_XCNT(j)  (256  + 64 * (j))
#define XB_XSUB(j)  (1280 + 64 * (j))
#define XB_XGEN(j)  (2304 + 64 * (j))
#define XB_TOP      3328
#define XB_TOPGEN   3392
#define XCD_BAR_WORDS 3456
#define XB_SPIN_CAP (1u << 18)

__device__ __forceinline__ unsigned xb_ld(unsigned* p)              { return __hip_atomic_load(p, __ATOMIC_RELAXED, __HIP_MEMORY_SCOPE_AGENT); }
__device__ __forceinline__ unsigned xb_add(unsigned* p, unsigned v) { return __hip_atomic_fetch_add(p, v, __ATOMIC_RELAXED, __HIP_MEMORY_SCOPE_AGENT); }
__device__ __forceinline__ unsigned xb_xcc_id() { return (unsigned)__builtin_amdgcn_s_getreg((3 << 11) | 20) & 0xFu; }
#define XB_SPIN(cond, bar) do { unsigned _sp = 0; while (cond) { __builtin_amdgcn_s_sleep(1); \
    if ((++_sp & 255u) == 0u) { if (xb_ld(&(bar)[XB_TMO])) break; if (_sp > XB_SPIN_CAP) { atomicAdd(&(bar)[XB_TMO], 1u); break; } } } } while (0)

struct XcdBarrier {
    unsigned* bar; unsigned x;
    volatile LAS unsigned* st;
};

__device__ __forceinline__ XcdBarrier xcd_barrier_post(unsigned* bar, volatile LAS unsigned* st) {
    XcdBarrier b; b.bar = bar; b.x = xb_xcc_id(); b.st = st;
    if (threadIdx.x == 0) (void)xb_add(&bar[XB_XCNT(b.x)], 1u);
    return b;
}
__device__ __forceinline__ void xcd_barrier_complete(unsigned* bar, unsigned x, unsigned& nloc, unsigned& nx) {
    const unsigned G = gridDim.x * gridDim.y * gridDim.z;
    unsigned sum, cnt, mine, sp = 0u;
    for (;;) {
        sum = 0u; cnt = 0u; mine = 0u;
#pragma unroll
        for (unsigned j = 0; j < 16; ++j) { const unsigned c = xb_ld(&bar[XB_XCNT(j)]); sum += c; cnt += (c > 0u) ? 1u : 0u; mine = (j == x) ? c : mine; }
        if (sum == G) break;
        __builtin_amdgcn_s_sleep(1);
        if ((++sp & 255u) == 0u) { if (xb_ld(&bar[XB_TMO])) break; if (sp > XB_SPIN_CAP) { atomicAdd(&bar[XB_TMO], 1u); break; } }
    }
    nloc = mine > 0u ? mine : 1u; nx = cnt > 0u ? cnt : 1u;
}

__device__ __forceinline__ void xcd_barrier(const XcdBarrier& b) {
    asm volatile("s_waitcnt vmcnt(0)" ::: "memory");
    __syncthreads();
    if (threadIdx.x == 0) {
        unsigned* bar = b.bar;
        __builtin_amdgcn_s_waitcnt(0);
        unsigned nloc = b.st[0], nx = b.st[1];
        if (nloc == 0u) { xcd_barrier_complete(bar, b.x, nloc, nx); b.st[0] = nloc; b.st[1] = nx; }
        const unsigned old = xb_add(&bar[XB_XSUB(b.x)], 1u);
        const unsigned gen = old / nloc;
        if (old + 1u == (gen + 1u) * nloc) {
            __builtin_amdgcn_fence(__ATOMIC_RELEASE, "agent");
            asm volatile("s_waitcnt vmcnt(0)" ::: "memory");
            const unsigned og = xb_add(&bar[XB_TOP], 1u);
            const unsigned tg = og / nx;
            if (og + 1u == (tg + 1u) * nx) xb_add(&bar[XB_TOPGEN], 1u);
            else XB_SPIN(xb_ld(&bar[XB_TOPGEN]) == tg, bar);
            __builtin_amdgcn_fence(__ATOMIC_ACQUIRE, "agent");
            xb_add(&bar[XB_XGEN(b.x)], 1u);
            asm volatile("s_waitcnt vmcnt(0)" ::: "memory");
        } else {
            XB_SPIN(xb_ld(&bar[XB_XGEN(b.x)]) == gen, bar);
            __builtin_amdgcn_fence(__ATOMIC_ACQUIRE, "agent");
            asm volatile("s_waitcnt vmcnt(0)" ::: "memory");
        }
    }
    __syncthreads();
}
__device__ __forceinline__ f32x4 mm16(const LAS unsigned char* A, int lda, const LAS unsigned char* Bt, int ldb, int ksteps, f32x4 acc, int l15, int quad) {
    const LAS unsigned char* ap = A + l15 * lda + quad * 16; const LAS unsigned char* bp = Bt + l15 * ldb + quad * 16;
    for (int kk = 0; kk < ksteps; ++kk) {
        const bf16x8 a = *(const LAS bf16x8*)(ap + kk * 64), b = *(const LAS bf16x8*)(bp + kk * 64);
        acc = __builtin_amdgcn_mfma_f32_16x16x32_bf16(a, b, acc, 0, 0, 0);
    }
    return acc;
}

#define LDS_BARRIER() do { asm volatile("s_waitcnt lgkmcnt(0)" ::: "memory"); __builtin_amdgcn_s_barrier(); asm volatile("" ::: "memory"); } while (0)
struct AB { float a, b; };
__device__ __forceinline__ AB comb(AB e1, AB e2) { AB r; r.a = e1.a * e2.a; r.b = e2.a * e1.b + e2.b; return r; }
__device__ __forceinline__ AB shfl_ab_up(AB v, int d) { AB r; r.a = __shfl_up(v.a, d); r.b = __shfl_up(v.b, d); return r; }
__device__ __forceinline__ AB shfl_ab_dn(AB v, int d) { AB r; r.a = __shfl_down(v.a, d); r.b = __shfl_down(v.b, d); return r; }
__device__ __forceinline__ AB shfl_ab(AB v, int l) { AB r; r.a = __shfl(v.a, l); r.b = __shfl(v.b, l); return r; }
constexpr int RG_U32 = 0, RG_UBF = 33792, RG_OSUM = RG_UBF + 17408, RG_CW = RG_OSUM + 33792, RG_END = RG_CW + 2560;
template <int PASS> __device__ __forceinline__ void rglru_items(const bf16* GR, const float* convw, const float* convb, const bf16* WG, const float* gateb, const float* lam,
                                                                float* CARRY, const float* HIN, bf16* Y, LAS unsigned char* lds, int bid, int G, int tid) {
    const int lane = tid & 63, w = tid >> 6, l15 = lane & 15, quad = lane >> 4;
    LAS float* U32 = (LAS float*)(lds + RG_U32); LAS unsigned char* UBF = lds + RG_UBF; LAS float* OSUM = (LAS float*)(lds + RG_OSUM);
    int kcur = -1; float sp[2], gb[2][2]; bf16x8 bfr[2][2][4]; LAS float* CW = (LAS float*)(lds + RG_CW);
    u32x4 pre[4][2]; bool pre_ok[4];
    const int tt = tid >> 3, cg = tid & 7;
#define RG_SEQ(r0_, s0_, s1_) do { if ((r0_) < MLAT) { s0_ = (r0_) & ~(SEQ - 1); s1_ = s0_ + SEQ; } else { s0_ = MLAT + (((r0_) - MLAT) & ~(CTXL - 1)); s1_ = s0_ + CTXL; } } while (0)
#define RG_PREFETCH(item_) do { const int k_ = (item_) & 15, r0_ = ((item_) >> 4) * 64; int s0_, s1_; RG_SEQ(r0_, s0_, s1_); const int c0_ = k_ * 128 + cg * 16; \
        _Pragma("unroll") for (int j = 0; j < 4; ++j) { const int rr = r0_ + tt + j - 2; pre_ok[j] = rr >= s0_ && rr < s1_; \
            if (pre_ok[j]) { pre[j][0] = *(const u32x4*)(GR + (size_t)rr * 4096 + 2048 + c0_); pre[j][1] = *(const u32x4*)(GR + (size_t)rr * 4096 + 2048 + c0_ + 8); } } } while (0)
    if (bid < 520 * 16) RG_PREFETCH(bid);
    for (int item = bid; item < 520 * 16; item += G) {
        const int k = item & 15, ch = item >> 4, r0 = ch * 64;
        const int c = k * 128 + 16 * w + l15;
        if (k != kcur) { kcur = k;
#pragma unroll
            for (int d = 0; d < 2; ++d)
#pragma unroll
                for (int g = 0; g < 2; ++g)
#pragma unroll
                    for (int kk = 0; kk < 4; ++kk) bfr[d][g][kk] = *(const bf16x8*)(WG + ((size_t)k * 512 + (d * 2 + g) * 128 + 16 * w + l15) * 128 + kk * 32 + quad * 8);
            LDS_BARRIER();
            for (int i = tid; i < 5 * 128; i += NTHR) { const int j = i >> 7, cc_ = i & 127; CW[i] = j < 4 ? convw[j * 2048 + k * 128 + cc_] : convb[k * 128 + cc_]; }
            LDS_BARRIER();
        }
        {
            float acc[16];
#pragma unroll
            for (int v = 0; v < 4; ++v) { const f32x4 b4 = *(const LAS f32x4*)(CW + 4 * 128 + cg * 16 + 4 * v); acc[4 * v] = b4.x; acc[4 * v + 1] = b4.y; acc[4 * v + 2] = b4.z; acc[4 * v + 3] = b4.w; }
#pragma unroll
            for (int j = 0; j < 4; ++j) { if (pre_ok[j]) { float x0[8], x1[8]; unpack8(pre[j][0], x0); unpack8(pre[j][1], x1);
#pragma unroll
                    for (int v = 0; v < 2; ++v) { const f32x4 wa = *(const LAS f32x4*)(CW + j * 128 + cg * 16 + 4 * v), wb = *(const LAS f32x4*)(CW + j * 128 + cg * 16 + 8 + 4 * v);
                        acc[4 * v] += wa.x * x0[4 * v]; acc[4 * v + 1] += wa.y * x0[4 * v + 1]; acc[4 * v + 2] += wa.z * x0[4 * v + 2]; acc[4 * v + 3] += wa.w * x0[4 * v + 3];
                        acc[8 + 4 * v] += wb.x * x1[4 * v]; acc[8 + 4 * v + 1] += wb.y * x1[4 * v + 1]; acc[8 + 4 * v + 2] += wb.z * x1[4 * v + 2]; acc[8 + 4 * v + 3] += wb.w * x1[4 * v + 3]; } } }
#pragma unroll
            for (int v = 0; v < 4; ++v) *(LAS f32x4*)(U32 + tt * 132 + cg * 16 + 4 * v) = (f32x4){acc[4 * v], acc[4 * v + 1], acc[4 * v + 2], acc[4 * v + 3]};
            float f0[8], f1[8];
#pragma unroll
            for (int e = 0; e < 8; ++e) { f0[e] = acc[e]; f1[e] = acc[8 + e]; }
            *(LAS u32x4*)(UBF + tt * 272 + cg * 32) = pack8(f0); *(LAS u32x4*)(UBF + tt * 272 + cg * 32 + 16) = pack8(f1);
        }
        if (item + G < 520 * 16) RG_PREFETCH(item + G);
        LDS_BARRIER();
#pragma unroll
        for (int d = 0; d < 2; ++d) { const float y = fexp(-lam[d * 2048 + c]); sp[d] = (y < 0.03f) ? y * (1.f - y * (0.5f - y * (0.33333334f - 0.25f * y))) : flog(1.f + y);
            gb[d][0] = gateb[(d * 2 + 0) * 2048 + c]; gb[d][1] = gateb[(d * 2 + 1) * 2048 + c]; }
        float Aa[2][4][4], Bx[2][4][4];
#pragma unroll
        for (int rb = 0; rb < 4; ++rb) {
            f32x4 ac[2][2] = {{{0.f, 0.f, 0.f, 0.f}, {0.f, 0.f, 0.f, 0.f}}, {{0.f, 0.f, 0.f, 0.f}, {0.f, 0.f, 0.f, 0.f}}};
#pragma unroll
            for (int kk = 0; kk < 4; ++kk) { const bf16x8 a = *(const LAS bf16x8*)(UBF + (rb * 16 + l15) * 272 + kk * 64 + quad * 16);
#pragma unroll
                for (int d = 0; d < 2; ++d)
#pragma unroll
                    for (int g = 0; g < 2; ++g) ac[d][g] = __builtin_amdgcn_mfma_f32_16x16x32_bf16(a, bfr[d][g][kk], ac[d][g], 0, 0, 0); }
#pragma unroll
            for (int i = 0; i < 4; ++i) { const float uv = U32[(rb * 16 + quad * 4 + i) * 132 + 16 * w + l15];
#pragma unroll
                for (int d = 0; d < 2; ++d) { const float rg = sigm(ac[d][0][i] + gb[d][0]), ig = sigm(ac[d][1][i] + gb[d][1]);
                    const float la = -8.f * rg * sp[d], z = 2.f * la, av = fexp(la); const float om = (z > -0.01f) ? -z * (1.f + z * (0.5f + z * 0.16666667f)) : 1.f - av * av;
                    Aa[d][rb][i] = av; Bx[d][rb][i] = __builtin_amdgcn_sqrtf(om) * ig * uv; } }
        }
        u32x4 gq0, gq1;
        if (PASS == 2) { gq0 = *(const u32x4*)(GR + (size_t)(r0 + tt) * 4096 + k * 128 + cg * 16); gq1 = *(const u32x4*)(GR + (size_t)(r0 + tt) * 4096 + k * 128 + cg * 16 + 8); }
        float hs[4][4];
#pragma unroll
        for (int rb = 0; rb < 4; ++rb)
#pragma unroll
            for (int i = 0; i < 4; ++i) hs[rb][i] = 0.f;
#pragma unroll
        for (int d = 0; d < 2; ++d) {
            AB tot; tot.a = 1.f; tot.b = 0.f; float Hc = 0.f;
            if (PASS == 2) Hc = HIN[((size_t)ch * 2 + d) * 2048 + c];
#pragma unroll
            for (int rbi = 0; rbi < 4; ++rbi) { const int rb = d == 0 ? rbi : 3 - rbi;
                AB seg; seg.a = 1.f; seg.b = 0.f;
#pragma unroll
                for (int ii = 0; ii < 4; ++ii) { const int i = d == 0 ? ii : 3 - ii; seg.b = Aa[d][rb][i] * seg.b + Bx[d][rb][i]; seg.a = seg.a * Aa[d][rb][i]; }
                AB inc = seg, t, rbt, ex;
                if (d == 0) { t = shfl_ab_up(inc, 16); if (quad >= 1) inc = comb(t, inc); t = shfl_ab_up(inc, 32); if (quad >= 2) inc = comb(t, inc); rbt = shfl_ab(inc, 48 + l15);
                              ex = shfl_ab_up(inc, 16); if (quad == 0) { ex.a = 1.f; ex.b = 0.f; } }
                else        { t = shfl_ab_dn(inc, 16); if (quad <= 2) inc = comb(t, inc); t = shfl_ab_dn(inc, 32); if (quad <= 1) inc = comb(t, inc); rbt = shfl_ab(inc, l15);
                              ex = shfl_ab_dn(inc, 16); if (quad == 3) { ex.a = 1.f; ex.b = 0.f; } }
                if (PASS == 1) tot = comb(tot, rbt);
                else { float s = ex.a * Hc + ex.b;
#pragma unroll
                    for (int ii = 0; ii < 4; ++ii) { const int i = d == 0 ? ii : 3 - ii; s = Aa[d][rb][i] * s + Bx[d][rb][i]; hs[rb][i] += s; }
                    Hc = rbt.a * Hc + rbt.b; }
            }
            if (PASS == 1 && quad == 0) { CARRY[(((size_t)ch * 2 + d) * 2 + 0) * 2048 + c] = tot.a; CARRY[(((size_t)ch * 2 + d) * 2 + 1) * 2048 + c] = tot.b; }
        }
        if (PASS == 2) {
#pragma unroll
            for (int rb = 0; rb < 4; ++rb)
#pragma unroll
                for (int i = 0; i < 4; ++i) OSUM[(rb * 16 + quad * 4 + i) * 132 + 16 * w + l15] = hs[rb][i];
            LDS_BARRIER();
            const int r = r0 + tt, c0 = k * 128 + cg * 16;
            float g0[8], g1[8], o0[8], o1[8]; unpack8(gq0, g0); unpack8(gq1, g1);
#pragma unroll
            for (int e = 0; e < 8; ++e) { const float x = g0[e], x2 = g1[e];
                o0[e] = x * sigm(1.5957691216f * (x + 0.044715f * x * x * x)) * OSUM[tt * 132 + cg * 16 + e];
                o1[e] = x2 * sigm(1.5957691216f * (x2 + 0.044715f * x2 * x2 * x2)) * OSUM[tt * 132 + cg * 16 + 8 + e]; }
            *(u32x4*)(Y + (size_t)r * DM + c0) = pack8(o0); *(u32x4*)(Y + (size_t)r * DM + c0 + 8) = pack8(o1);
        }
        LDS_BARRIER();
    }
}
__device__ __forceinline__ void rglru_prop(const float* __restrict__ CARRY, float* __restrict__ HIN, LAS float* sm, int bid, int G, int tid) {
    const int cl = tid & 31, seg = tid >> 5;
    for (int grp = bid; grp < 256; grp += G) {
        const int c = (grp & 63) * 32 + cl, d = (grp >> 6) & 1, b = grp >> 7;
        float a[20], bb[20]; int chs[20]; float A = 1.f, B = 0.f;
        if (seg < 13) {
#pragma unroll
            for (int k = 0; k < 20; ++k) { const int step = seg * 20 + k;
                int ch; if (d == 0) ch = step < 4 ? (512 + 4 * b + step) : (256 * b + step - 4); else ch = step < 4 ? (512 + 4 * b + 3 - step) : (256 * b + 255 - (step - 4));
                chs[k] = ch; a[k] = CARRY[(((size_t)ch * 2 + d) * 2 + 0) * 2048 + c]; bb[k] = CARRY[(((size_t)ch * 2 + d) * 2 + 1) * 2048 + c]; }
#pragma unroll
            for (int k = 0; k < 20; ++k) { B = a[k] * B + bb[k]; A = a[k] * A; }
            sm[(seg * 32 + cl) * 2] = A; sm[(seg * 32 + cl) * 2 + 1] = B;
        }
        __syncthreads();
        if (seg < 13) { float H = 0.f;
            for (int q = 0; q < seg; ++q) H = sm[(q * 32 + cl) * 2] * H + sm[(q * 32 + cl) * 2 + 1];
#pragma unroll
            for (int k = 0; k < 20; ++k) { HIN[((size_t)chs[k] * 2 + d) * 2048 + c] = H; H = a[k] * H + bb[k]; } }
        __syncthreads();
    }
}

constexpr int GL_QT = 0, GL_KT = 17408, GL_QS = 34816, GL_KST = 52224, GL_VT = 70656, GL_ST = 89088, GL_PP = 123904, GL_SEGT = 133120, GL_DVEC = 135168, GL_END = 135680;
static_assert(GL_END <= RING_BYTES && RG_END <= RING_BYTES, "LDS");
template <int PASS> __device__ __forceinline__ void gla_items(const bf16* HG, const float* lbv, float* ST, float* DVG, bf16* OFb, bf16* OBb, LAS unsigned char* lds, int bid, int G, int tid) {
    const int lane = tid & 63, w = tid >> 6, l15 = lane & 15, quad = lane >> 4;
    const int dk = tid & 127, seg = tid >> 7;
    LAS float* SEGT = (LAS float*)(lds + GL_SEGT); LAS float* DVEC = (LAS float*)(lds + GL_DVEC);
    const size_t SECE = (size_t)MROWS * DM;
    u32x4 rz[2], rv[2], rq[2];
#define GL_DECODE(item_, sc_, h_, d_, b_, R0_) const int sc_ = (item_) % 65, h_ = ((item_) / 65) & 15, d_ = ((item_) / 1040) & 1, b_ = (item_) / 2080; \
        const int R0_ = sc_ == 0 ? MLAT + CTXL * b_ : SEQ * b_ + 256 * (d_ == 0 ? sc_ - 1 : 64 - sc_)
#define GL_FETCH(item_, cc_) do { GL_DECODE(item_, fsc_, fh_, fd_, fb_, fR0_); (void)fsc_; (void)fb_; \
        _Pragma("unroll") for (int hf = 0; hf < 2; ++hf) { const int p = (tid >> 4) + 32 * hf; const int tok = fd_ == 0 ? fR0_ + 64 * (cc_) + p : fR0_ + 255 - 64 * (cc_) - p; \
            const bf16* rowp = HG + (size_t)tok * DM + fh_ * 128 + (tid & 15) * 8; \
            rz[hf] = *(const u32x4*)(rowp + (size_t)(1 + fd_) * SECE); rv[hf] = *(const u32x4*)(rowp + 3 * SECE); if (PASS == 2) rq[hf] = *(const u32x4*)rowp; } } while (0)
    unsigned tch = 0u;
#define GL_TOUCH(item_, cc_) do { if (tid < (PASS == 2 ? 384 : 256)) { GL_DECODE(item_, tsc_, th_, td_, tb_, tR0_); (void)tsc_; (void)tb_; const int p = tid & 63, hl = (tid >> 6) & 1, sec = tid >> 7; \
            const int tok = td_ == 0 ? tR0_ + 64 * (cc_) + p : tR0_ + 255 - 64 * (cc_) - p; \
            tch = *(const unsigned*)(HG + (size_t)tok * DM + th_ * 128 + hl * 64 + (size_t)(sec == 0 ? 1 + td_ : sec == 1 ? 3 : 0) * SECE); } } while (0)
    if (bid < 4160) { GL_FETCH(bid, 0); GL_TOUCH(bid, 1); }
    for (int item = bid; item < 4160; item += G) {
        GL_DECODE(item, sc, h, d, b, R0); (void)sc; (void)b;
        const float lb = lbv[d * 2048 + h * 128 + dk], oml = 1.f - lb;
        bf16* OD = d == 0 ? OFb : OBb;
        f32x4 sacc[8];
#pragma unroll
        for (int j = 0; j < 8; ++j) sacc[j] = (f32x4){0.f, 0.f, 0.f, 0.f};
        if (PASS == 2) {
            const float* sp = ST + (size_t)item * 16384;
#pragma unroll
            for (int j = 0; j < 8; ++j)
#pragma unroll
                for (int i = 0; i < 4; ++i) { const float v = sp[(16 * w + quad * 4 + i) * 128 + 16 * j + l15]; sacc[j][i] = v;
                    *(LAS unsigned short*)(lds + GL_ST + (16 * w + quad * 4 + i) * 272 + (16 * j + l15) * 2) = f2bf(v); }
        }
        float ctotal = 0.f;
        for (int cc = 0; cc < 4; ++cc) {
#pragma unroll
            for (int hf = 0; hf < 2; ++hf) { const int p = (tid >> 4) + 32 * hf, c16 = tid & 15;
                *(LAS u32x4*)(lds + GL_KT + p * 272 + c16 * 16) = rz[hf]; *(LAS u32x4*)(lds + GL_QS + p * 272 + c16 * 16) = rv[hf];
                if (PASS == 2) *(LAS u32x4*)(lds + GL_QT + p * 272 + c16 * 16) = rq[hf]; }
            LDS_BARRIER();
            asm volatile("" :: "v"(tch));
            if (cc < 3) GL_FETCH(item, cc + 1); else if (item + G < 4160) GL_FETCH(item + G, 0);
            if (cc < 2) GL_TOUCH(item, cc + 2); else if (item + G < 4160) GL_TOUCH(item + G, cc - 2);
            float lc[16], kv[16], vv[16], qq[16]; float run = 0.f;
#pragma unroll
            for (int i = 0; i < 16; ++i) { const int p = 16 * seg + i;
                const float z = bf2f(*(const LAS unsigned short*)(lds + GL_KT + p * 272 + dk * 2)); vv[i] = bf2f(*(const LAS unsigned short*)(lds + GL_QS + p * 272 + dk * 2));
                if (PASS == 2) qq[i] = silu(bf2f(*(const LAS unsigned short*)(lds + GL_QT + p * 272 + dk * 2)));
                const float e = fexp(-z), inv = frcp(1.f + e); kv[i] = oml * e * inv; const float f = lb + oml * inv; run += flog(f); lc[i] = run; }
            SEGT[seg * 128 + dk] = run;
            LDS_BARRIER();
            const float t0 = SEGT[dk], t1 = SEGT[128 + dk], t2 = SEGT[256 + dk], t3 = SEGT[384 + dk];
            const float off = seg == 0 ? 0.f : seg == 1 ? t0 : seg == 2 ? t0 + t1 : t0 + t1 + t2; const float cref = t0 + t1, clast = (t0 + t1) + (t2 + t3);
            ctotal += clast;
            float ks[16];
            const float ecr = fexp(cref), ecl = fexp(clast - cref);
#pragma unroll
            for (int i = 0; i < 16; ++i) { const int p = 16 * seg + i; const float cum = off + lc[i];
                if (PASS == 2) { const float e1 = fexp(cum - cref), e2 = fexp(cref - cum), qe = qq[i] * e1, ke = kv[i] * e2; ks[i] = ke * ecl;
                    *(LAS unsigned short*)(lds + GL_QT + p * 272 + dk * 2) = f2bf(qe);
                    *(LAS unsigned short*)(lds + GL_KT + p * 272 + dk * 2) = f2bf(ke);
                    *(LAS unsigned short*)(lds + GL_QS + p * 272 + dk * 2) = f2bf(qe * ecr); }
                else ks[i] = kv[i] * fexp(clast - cum); }
            { float f0[8], f1[8];
#pragma unroll
              for (int e = 0; e < 8; ++e) { f0[e] = ks[e]; f1[e] = ks[8 + e]; }
              *(LAS u32x4*)(lds + GL_KST + dk * 144 + seg * 32) = pack8(f0); *(LAS u32x4*)(lds + GL_KST + dk * 144 + seg * 32 + 16) = pack8(f1);
#pragma unroll
              for (int e = 0; e < 8; ++e) { f0[e] = vv[e]; f1[e] = vv[8 + e]; }
              *(LAS u32x4*)(lds + GL_VT + dk * 144 + seg * 32) = pack8(f0); *(LAS u32x4*)(lds + GL_VT + dk * 144 + seg * 32 + 16) = pack8(f1); }
            if (seg == 0) DVEC[dk] = fexp(clast);
            LDS_BARRIER();
            if (PASS == 2) {
                const int pb = w >> 1;
#pragma unroll
                for (int sbl = 0; sbl < 2; ++sbl) { const int sb = 2 * (w & 1) + sbl; f32x4 a4 = {0.f, 0.f, 0.f, 0.f};
                    if (sb <= pb) a4 = mm16(lds + GL_QT + pb * 16 * 272, 272, lds + GL_KT + sb * 16 * 272, 272, 4, a4, l15, quad);
#pragma unroll
                    for (int i = 0; i < 4; ++i) { const int p = pb * 16 + quad * 4 + i, s = sb * 16 + l15; const float v = (sb <= pb && s <= p) ? a4[i] : 0.f;
                        *(LAS unsigned short*)(lds + GL_PP + p * 144 + s * 2) = f2bf(v); } }
                LDS_BARRIER();
#pragma unroll
                for (int dvl = 0; dvl < 4; ++dvl) { const int dvb = 4 * (w & 1) + dvl; f32x4 o4 = {0.f, 0.f, 0.f, 0.f};
                    o4 = mm16(lds + GL_PP + pb * 16 * 144, 144, lds + GL_VT + dvb * 16 * 144, 144, 2, o4, l15, quad);
                    o4 = mm16(lds + GL_QS + pb * 16 * 272, 272, lds + GL_ST + dvb * 16 * 272, 272, 4, o4, l15, quad);
#pragma unroll
                    for (int i = 0; i < 4; ++i) { const int p = pb * 16 + quad * 4 + i; const int tok = d == 0 ? R0 + 64 * cc + p : R0 + 255 - 64 * cc - p;
                        OD[(size_t)tok * DM + h * 128 + dvb * 16 + l15] = f2bf(o4[i]); } }
            }
#pragma unroll
            for (int j = 0; j < 8; ++j) { const float dd = DVEC[16 * j + l15]; sacc[j] = sacc[j] * dd;
                sacc[j] = mm16(lds + GL_VT + w * 16 * 144, 144, lds + GL_KST + j * 16 * 144, 144, 2, sacc[j], l15, quad); }
            if (PASS == 2) {
                LDS_BARRIER();
#pragma unroll
                for (int j = 0; j < 8; ++j)
#pragma unroll
                    for (int i = 0; i < 4; ++i) *(LAS unsigned short*)(lds + GL_ST + (16 * w + quad * 4 + i) * 272 + (16 * j + l15) * 2) = f2bf(sacc[j][i]);
            }
            LDS_BARRIER();
        }
        if (PASS == 1) {
            float* sp = ST + (size_t)item * 16384;
#pragma unroll
            for (int j = 0; j < 8; ++j)
#pragma unroll
                for (int i = 0; i < 4; ++i) sp[(16 * w + quad * 4 + i) * 128 + 16 * j + l15] = sacc[j][i];
            if (seg == 0) DVG[(size_t)item * 128 + dk] = fexp(ctotal);
        }
    }
}
__device__ __forceinline__ void gla_prop(float* ST, const float* __restrict__ DVG, int gt, int NGT) {
    for (int id = gt; id < 64 * 4096; id += NGT) {
        const int bdh = id >> 12, e = (id & 4095) * 4; f32x4 S = {0.f, 0.f, 0.f, 0.f};
        for (int s0 = 0; s0 < 65; s0 += 13) { f32x4 t[13], dd[13];
#pragma unroll
            for (int k = 0; k < 13; ++k) { const size_t idx = (size_t)bdh * 65 + s0 + k; t[k] = *(const f32x4*)(ST + idx * 16384 + e); dd[k] = *(const f32x4*)(DVG + idx * 128 + (e & 127)); }
#pragma unroll
            for (int k = 0; k < 13; ++k) { const size_t idx = (size_t)bdh * 65 + s0 + k; *(f32x4*)(ST + idx * 16384 + e) = S; S = dd[k] * S + t[k]; } }
    }
}
namespace att {
using s16x4  = __attribute__((ext_vector_type(4))) short;
using f32x16 = __attribute__((ext_vector_type(16))) float;
constexpr int NW = 8, QBLK = 32, KVBLK = 64;
#define ATT_SBAR() __builtin_amdgcn_sched_barrier(0)
__device__ __forceinline__ int crow(int r, int hi) { return (r & 3) + 8 * (r >> 2) + 4 * hi; }
__device__ __forceinline__ unsigned cvtpk(float lo, float hi) { unsigned r; asm volatile("v_cvt_pk_bf16_f32 %0, %1, %2" : "=v"(r) : "v"(lo), "v"(hi)); return r; }
__device__ __forceinline__ void partialSM(f32x16& p0, f32x16& p1, float& m_reg, float& mn, float& alpha, const float C, const float thr, const float fixref = 0.f) {
  float mnC;
  if (fixref > 0.f) {
    mn = m_reg; alpha = 1.f;
#pragma unroll
    for (int r = 0; r < 16; ++r) p0[r] = __builtin_amdgcn_exp2f(p0[r]);
    return;
  }
  {
  float pmax = p0[0];
#pragma unroll
  for (int r = 1; r < 16; ++r) pmax = fmaxf(pmax, p0[r]);
#pragma unroll
  for (int r = 0; r < 16; ++r) pmax = fmaxf(pmax, p1[r]);
  { auto rr = __builtin_amdgcn_permlane32_swap(__float_as_uint(pmax), __float_as_uint(pmax), false, false);
    pmax = fmaxf(__uint_as_float(rr[0]), __uint_as_float(rr[1])); }
  if (__builtin_expect(__all(pmax - m_reg <= thr), 1)) { mn = m_reg; alpha = 1.f; }
  else { mn = fmaxf(m_reg, pmax); alpha = __builtin_amdgcn_exp2f((m_reg - mn) * C); m_reg = mn; }
  mnC = -mn * C;
  }
#pragma unroll
  for (int r = 0; r < 16; ++r) p0[r] = fmaf(p0[r], C, mnC);
#pragma unroll
  for (int r = 0; r < 16; ++r) p1[r] = fmaf(p1[r], C, mnC);
#pragma unroll
  for (int r = 0; r < 16; ++r) p0[r] = __builtin_amdgcn_exp2f(p0[r]);
}
__device__ __forceinline__ void finishSM(f32x16& p0, f32x16& p1, float alpha, float& l_reg, bf16x8& pa0, bf16x8& pa1, bf16x8& pa2, bf16x8& pa3) {
#pragma unroll
  for (int r = 0; r < 16; ++r) p1[r] = __builtin_amdgcn_exp2f(p1[r]);
  float ps = 0;
#pragma unroll
  for (int r = 0; r < 16; ++r) ps += p0[r];
#pragma unroll
  for (int r = 0; r < 16; ++r) ps += p1[r];
  { auto rr = __builtin_amdgcn_permlane32_swap(__float_as_uint(ps), __float_as_uint(ps), false, false);
    ps = __uint_as_float(rr[0]) + __uint_as_float(rr[1]); }
  l_reg = l_reg * alpha + ps;
#define ATT_PK4(P, BASE, OUT) do { unsigned a0 = cvtpk(P[BASE + 0], P[BASE + 1]), a1 = cvtpk(P[BASE + 2], P[BASE + 3]);   \
    unsigned b0 = cvtpk(P[BASE + 4], P[BASE + 5]), b1 = cvtpk(P[BASE + 6], P[BASE + 7]);                              \
    auto r0 = __builtin_amdgcn_permlane32_swap(a0, b0, false, false); auto r1 = __builtin_amdgcn_permlane32_swap(a1, b1, false, false); \
    u32x4 w = {r0[0], r1[0], r0[1], r1[1]}; OUT = *reinterpret_cast<bf16x8*>(&w); } while (0)
  ATT_PK4(p0, 0, pa0); ATT_PK4(p0, 8, pa1); ATT_PK4(p1, 0, pa2); ATT_PK4(p1, 8, pa3);
#undef ATT_PK4
}
template <int DQK> __device__ __forceinline__ int kswz(int row, int colB) {
  if (DQK == 128) return row * 256 + (colB ^ ((row & 7) << 4));
  return row * 400 + colB;
}
template <int DQK> __device__ __forceinline__ void qkt(f32x16& p0, f32x16& p1, const char* Ks, const bf16x8* qr, int r32, int hi) {
  p0 = f32x16{}; p1 = f32x16{};
#pragma unroll
  for (int d0 = 0; d0 < DQK / 16; ++d0) { const int cb = (d0 * 16 + hi * 8) * 2;
    const bf16x8 b0 = *reinterpret_cast<const bf16x8*>(Ks + kswz<DQK>(r32, cb));
    const bf16x8 b1 = *reinterpret_cast<const bf16x8*>(Ks + kswz<DQK>(32 + r32, cb));
    p0 = __builtin_amdgcn_mfma_f32_32x32x16_bf16(b0, qr[d0], p0, 0, 0, 0);
    p1 = __builtin_amdgcn_mfma_f32_32x32x16_bf16(b1, qr[d0], p1, 0, 0, 0); }
}
__device__ __forceinline__ int v_st(int k, int c) { const int kk = (k & ~0xC) | ((k & 4) << 1) | ((k & 8) >> 1); return ((kk >> 3) * 4 + (c >> 5)) * 512 + ((kk & 7) * 32 + (c & 31)) * 2; }
__device__ __forceinline__ int v_rd_base(int lane) { return ((lane & 3) << 3) | (((lane >> 2) & 3) << 6) | (((lane >> 4) & 1) << 5) | (((lane >> 5) & 1) << 8); }
constexpr int v_rd_off(int d0, int ks, int half) { return d0 * 512 + ks * 4096 + half * 2048; }
template <int OFF> __device__ __forceinline__ s16x4 tr_read(int vb) { s16x4 r; asm volatile("ds_read_b64_tr_b16 %0, %1 offset:%2" : "=&v"(r) : "v"(vb), "i"(OFF) : "memory"); return r; }
template <int D0> __device__ __forceinline__ void pv_one(f32x16& od, int vb, bf16x8 pa0, bf16x8 pa1, bf16x8 pa2, bf16x8 pa3) {
  const s16x4 l0 = tr_read<v_rd_off(D0, 0, 0)>(vb), h0 = tr_read<v_rd_off(D0, 0, 1)>(vb), l1 = tr_read<v_rd_off(D0, 1, 0)>(vb), h1 = tr_read<v_rd_off(D0, 1, 1)>(vb);
  const s16x4 l2 = tr_read<v_rd_off(D0, 2, 0)>(vb), h2 = tr_read<v_rd_off(D0, 2, 1)>(vb), l3 = tr_read<v_rd_off(D0, 3, 0)>(vb), h3 = tr_read<v_rd_off(D0, 3, 1)>(vb);
  asm volatile("s_waitcnt lgkmcnt(0)" ::: "memory"); ATT_SBAR();
#define ATT_PK(L, H) (bf16x8){L[0], L[1], L[2], L[3], H[0], H[1], H[2], H[3]}
  od = __builtin_amdgcn_mfma_f32_32x32x16_bf16(pa0, ATT_PK(l0, h0), od, 0, 0, 0);
  od = __builtin_amdgcn_mfma_f32_32x32x16_bf16(pa1, ATT_PK(l1, h1), od, 0, 0, 0);
  od = __builtin_amdgcn_mfma_f32_32x32x16_bf16(pa2, ATT_PK(l2, h2), od, 0, 0, 0);
  od = __builtin_amdgcn_mfma_f32_32x32x16_bf16(pa3, ATT_PK(l3, h3), od, 0, 0, 0);
#undef ATT_PK
}
__device__ __forceinline__ void pv_d0(f32x16* o, int vb, bf16x8 pa0, bf16x8 pa1, bf16x8 pa2, bf16x8 pa3) {
  pv_one<0>(o[0], vb, pa0, pa1, pa2, pa3); pv_one<1>(o[1], vb, pa0, pa1, pa2, pa3); pv_one<2>(o[2], vb, pa0, pa1, pa2, pa3); pv_one<3>(o[3], vb, pa0, pa1, pa2, pa3);
}
template <int MODE> __device__ __forceinline__ void maskt(f32x16& p0, f32x16& p1, int t, int band0, int qpos, int hi) {
  if (MODE != 1) return;
  if (t < 4) return;
  const int pos0 = band0 + 64 * (t - 4);
#pragma unroll
  for (int r = 0; r < 16; ++r) { const int kp = pos0 + crow(r, hi); const int dq = qpos - kp, dq2 = dq - 32;
    const bool ok0 = (unsigned)kp < (unsigned)SEQ && dq <= 128 && dq >= -128; const bool ok1 = (unsigned)(kp + 32) < (unsigned)SEQ && dq2 <= 128 && dq2 >= -128;
    if (!ok0) p0[r] = -1e30f; if (!ok1) p1[r] = -1e30f; }
}
template <int DQK, int MODE>
__device__ __forceinline__ void attn_unit(const bf16* __restrict__ Qb, int ldq, const bf16* __restrict__ Kp, int ldk, const bf16* __restrict__ Vp, int ldv, bf16* __restrict__ Ob, int ldo,
                                          int NT, int ctx0, int lat0, int band0, int q0, float SCALE, float sinkL2, char* lds) {
  constexpr int SHM_V = KVBLK * 128 * 2, SHM_K = KVBLK * DQK * 2, CH = DQK / 8, NKC = DQK / 64, SDEPTH = (DQK > 128 ? 1 : 2);
  const float C = SCALE * LOG2E, thr = 8.f / SCALE;
  const int tid = threadIdx.x, wid = tid >> 6, lane = tid & 63, r32 = lane & 31, hi = lane >> 5;
  char* V_lds = lds; char* K_lds = lds + 2 * SHM_V;
  float* wsf = (float*)(lds + 2 * SHM_V + 2 * SHM_K) + wid * 64; float* li_l = wsf; float* al_l = wsf + 32;
  float m_reg = -1e30f, l_reg = 0; f32x16 o[4] = {}; bf16x8 qr[DQK / 16];
  const bf16* Qw = Qb + (long)(wid * QBLK + r32) * ldq + hi * 8;
#pragma unroll
  for (int d0 = 0; d0 < DQK / 16; ++d0) qr[d0] = *reinterpret_cast<const bf16x8*>(Qw + d0 * 16);
  const int sr = tid >> 4, sc = (tid & 15) * 8, vst0 = v_st(sr, sc), vst1 = v_st(32 + sr, sc);
  const int vb0 = (int)(uintptr_t)V_lds + v_rd_base(lane);
  int krow[NKC], kcol[NKC];
#pragma unroll
  for (int c = 0; c < NKC; ++c) { const int id = tid + 512 * c; krow[c] = id / CH; kcol[c] = id % CH; }
  struct { bf16x8 vs0, vs1, ks[NKC]; } sr_[SDEPTH];
  const int qpos = q0 + wid * QBLK + r32;
#define ATT_TROW(t) ((t) < 4 ? ctx0 + 64 * (t) : (MODE == 0 ? lat0 + 64 * ((t) - 4) : lat0 + min(max(band0 + 64 * ((t) - 4), 0), SEQ - 64)))
#define ATT_SLOAD(i, t) do { const long row0_ = ATT_TROW(t); sr_[i].vs0 = *reinterpret_cast<const bf16x8*>(&Vp[(row0_ + sr) * ldv + sc]); sr_[i].vs1 = *reinterpret_cast<const bf16x8*>(&Vp[(row0_ + 32 + sr) * ldv + sc]); \
    _Pragma("unroll") for (int c_ = 0; c_ < NKC; ++c_) sr_[i].ks[c_] = *reinterpret_cast<const bf16x8*>(&Kp[(row0_ + krow[c_]) * ldk + kcol[c_] * 8]); } while (0)
#define ATT_SWRITE(b, i) do { *(bf16x8*)(V_lds + (b) * SHM_V + vst0) = sr_[i].vs0; *(bf16x8*)(V_lds + (b) * SHM_V + vst1) = sr_[i].vs1; \
    _Pragma("unroll") for (int c_ = 0; c_ < NKC; ++c_) *(bf16x8*)(K_lds + (b) * SHM_K + kswz<DQK>(krow[c_], kcol[c_] * 16)) = sr_[i].ks[c_]; } while (0)
#define ATT_SWAIT() asm volatile("s_waitcnt vmcnt(%0)" :: "n"(SDEPTH == 2 ? 2 + NKC : 0) : "memory")
#define ATT_RESC(a) do { if (__any((a) < 1.f)) { if (hi == 0) al_l[r32] = (a); asm volatile("s_waitcnt lgkmcnt(0)" ::: "memory"); \
    _Pragma("unroll") for (int d = 0; d < 4; ++d) _Pragma("unroll") for (int r = 0; r < 16; ++r) o[d][r] *= al_l[crow(r, hi)]; } } while (0)
  f32x16 pA0, pA1, pB0, pB1; float mnA, mnB, alA, alB; bf16x8 pa0, pa1, pa2, pa3;
  constexpr int SE = 0, SO = SDEPTH - 1;
  ATT_SLOAD(SE, 0); asm volatile("s_waitcnt vmcnt(0)" ::: "memory"); ATT_SWRITE(0, SE); __syncthreads();
  qkt<DQK>(pA0, pA1, K_lds, qr, r32, hi); maskt<MODE>(pA0, pA1, 0, band0, qpos, hi); partialSM(pA0, pA1, m_reg, mnA, alA, C, thr);
  ATT_SLOAD(SO, 1); if constexpr (SDEPTH == 2) { if (2 < NT) ATT_SLOAD(SE, 2); }
  ATT_SWAIT(); ATT_SWRITE(1, SO); __syncthreads();
  for (int j = 1; j + 1 < NT; j += 2) {
    ATT_SBAR(); qkt<DQK>(pB0, pB1, K_lds + SHM_K, qr, r32, hi); maskt<MODE>(pB0, pB1, j, band0, qpos, hi);
    finishSM(pA0, pA1, alA, l_reg, pa0, pa1, pa2, pa3); ATT_SBAR();
    ATT_SLOAD(SO, j + SDEPTH); ATT_SBAR();
    pv_d0(o, vb0, pa0, pa1, pa2, pa3); partialSM(pB0, pB1, m_reg, mnB, alB, C, thr);
    __syncthreads(); ATT_SWAIT(); ATT_SWRITE(0, SE);
    ATT_RESC(alB); __syncthreads();
    ATT_SBAR(); qkt<DQK>(pA0, pA1, K_lds, qr, r32, hi); maskt<MODE>(pA0, pA1, j + 1, band0, qpos, hi);
    finishSM(pB0, pB1, alB, l_reg, pa0, pa1, pa2, pa3); ATT_SBAR();
    if (SDEPTH == 1 || j + 3 < NT) ATT_SLOAD(SE, j + 1 + SDEPTH); ATT_SBAR();
    pv_d0(o, vb0 + SHM_V, pa0, pa1, pa2, pa3); partialSM(pA0, pA1, m_reg, mnA, alA, C, thr);
    __syncthreads(); ATT_SWAIT(); ATT_SWRITE(1, SO);
    ATT_RESC(alA); __syncthreads();
  }
  ATT_SBAR(); qkt<DQK>(pB0, pB1, K_lds + SHM_K, qr, r32, hi); maskt<MODE>(pB0, pB1, NT - 1, band0, qpos, hi);
  finishSM(pA0, pA1, alA, l_reg, pa0, pa1, pa2, pa3); ATT_SBAR();
  pv_d0(o, vb0, pa0, pa1, pa2, pa3); partialSM(pB0, pB1, m_reg, mnB, alB, C, thr);
  __syncthreads(); ATT_RESC(alB);
  finishSM(pB0, pB1, alB, l_reg, pa0, pa1, pa2, pa3); ATT_SBAR();
  pv_d0(o, vb0 + SHM_V, pa0, pa1, pa2, pa3);
  if (MODE == 1) l_reg += __builtin_amdgcn_exp2f(sinkL2 - m_reg * C);
  if (hi == 0) li_l[r32] = l_reg; asm volatile("s_waitcnt lgkmcnt(0)" ::: "memory");
  float rli[16];
#pragma unroll
  for (int r = 0; r < 16; ++r) rli[r] = __builtin_amdgcn_rcpf(li_l[crow(r, hi)]);
  bf16* Ow = Ob + (long)(wid * QBLK) * ldo;
#pragma unroll
  for (int r = 0; r < 16; ++r) { const int orow = crow(r, hi);
#pragma unroll
    for (int d0 = 0; d0 < 4; ++d0) Ow[(long)orow * ldo + d0 * 32 + r32] = f2bf(o[d0][r] * rli[r]); }
  __syncthreads();
#undef ATT_TROW
#undef ATT_SLOAD
#undef ATT_SWRITE
#undef ATT_SWAIT
#undef ATT_RESC
}

template <int DQK, int MODE, bool EARLY, int QP = 0>
__device__ __forceinline__ void attn_unit_simple(const bf16* __restrict__ Qb, int ldq, const bf16* __restrict__ Kp, int ldk, const bf16* __restrict__ Vp, int ldv, bf16* __restrict__ Ob, int ldo,
                                                 int NT, int ctx0, int lat0, int band0, int q0, float SCALE, float sinkL2, char* lds, float fixref = 0.f,
                                                 const float* __restrict__ qkg = nullptr, const float* __restrict__ tab = nullptr, float qscale = 1.f, int qrow0 = 0) {
  constexpr int SHM_V = KVBLK * 128 * 2, SHM_K = KVBLK * (DQK == 128 ? 256 : 400), CH = DQK / 8, NKC = DQK / 64;
  const float C = SCALE * LOG2E, thr = 8.f / SCALE;
  int tid_ = threadIdx.x; asm volatile("" : "+v"(tid_));
  const int tid = tid_, wid = tid >> 6, lane = tid & 63, r32 = lane & 31, hi = lane >> 5;
  char* V_lds = lds; char* K_lds = lds + 2 * SHM_V;
  float* wsf = (float*)(lds + 2 * SHM_V + 2 * SHM_K) + wid * 64; float* li_l = wsf; float* al_l = wsf + 32;
  float m_reg = -1e30f, l_reg = 0; f32x16 o[4] = {}; bf16x8 qr[DQK / 16];
  const bf16* Qw = Qb + (long)(wid * QBLK + r32) * ldq + hi * 8;
#pragma unroll
  for (int d0 = 0; d0 < DQK / 16; ++d0) qr[d0] = *reinterpret_cast<const bf16x8*>(Qw + d0 * 16);
  const int sr = tid >> 4, sc = (tid & 15) * 8, vst0 = v_st(sr, sc), vst1 = v_st(32 + sr, sc);
  const int vb0 = (int)(uintptr_t)V_lds + v_rd_base(lane);
  int krow[NKC], kcol[NKC];
#pragma unroll
  for (int c = 0; c < NKC; ++c) { const int id = tid + 512 * c; krow[c] = id / CH; kcol[c] = id % CH; }
  bf16x8 vs0, vs1, ksg[NKC];
  const int qpos = q0 + wid * QBLK + r32;
#define ATT_TROW(t) ((t) < 4 ? ctx0 + 64 * (t) : (MODE == 0 ? lat0 + 64 * ((t) - 4) : lat0 + min(max(band0 + 64 * ((t) - 4), 0), SEQ - 64)))
#define ATT_SLOAD(t) do { const long row0_ = ATT_TROW(t); vs0 = *reinterpret_cast<const bf16x8*>(&Vp[(row0_ + sr) * ldv + sc]); vs1 = *reinterpret_cast<const bf16x8*>(&Vp[(row0_ + 32 + sr) * ldv + sc]); \
    _Pragma("unroll") for (int c_ = 0; c_ < NKC; ++c_) ksg[c_] = *reinterpret_cast<const bf16x8*>(&Kp[(row0_ + krow[c_]) * ldk + kcol[c_] * 8]); } while (0)
#define ATT_SWRITE(b) do { *(bf16x8*)(V_lds + (b) * SHM_V + vst0) = vs0; *(bf16x8*)(V_lds + (b) * SHM_V + vst1) = vs1; \
    _Pragma("unroll") for (int c_ = 0; c_ < NKC; ++c_) *(bf16x8*)(K_lds + (b) * SHM_K + kswz<DQK>(krow[c_], kcol[c_] * 16)) = ksg[c_]; } while (0)
  ATT_SLOAD(0);
  if constexpr (QP == 1) {
    int hi8 = hi * 8; asm volatile("" : "+v"(hi8));
    float sn_ = 0.f, sr_ = 0.f;
#pragma unroll
    for (int d0 = 0; d0 < 12; ++d0) { float f[8]; unpack8(__builtin_bit_cast(u32x4, qr[d0]), f);
#pragma unroll
      for (int e = 0; e < 8; ++e) { if (d0 < 8) sn_ += f[e] * f[e]; else sr_ += f[e] * f[e]; } }
    { auto r0_ = __builtin_amdgcn_permlane32_swap(__float_as_uint(sn_), __float_as_uint(sn_), false, false); sn_ = __uint_as_float(r0_[0]) + __uint_as_float(r0_[1]);
      auto r1_ = __builtin_amdgcn_permlane32_swap(__float_as_uint(sr_), __float_as_uint(sr_), false, false); sr_ = __uint_as_float(r1_[0]) + __uint_as_float(r1_[1]); }
    const float rn = frsq(sn_ * (1.f / 128.f) + EPS), rr = frsq(sr_ * (1.f / 64.f) + EPS);
#pragma unroll
    for (int d0 = 0; d0 < 8; ++d0) { float f[8]; unpack8(__builtin_bit_cast(u32x4, qr[d0]), f); const float* gp = qkg + 16 * d0 + hi8; const f32x4 g0 = *(const f32x4*)gp, g1 = *(const f32x4*)(gp + 4);
#pragma unroll
      for (int e = 0; e < 4; ++e) { f[e] = f[e] * rn * (g0[e] * qscale); f[4 + e] = f[4 + e] * rn * (g1[e] * qscale); }
      qr[d0] = __builtin_bit_cast(bf16x8, pack8(f)); }
    const int m_ = qrow0 + wid * QBLK + r32; const bool isl = m_ < MLAT; const int t_ = m_ & (SEQ - 1);
#pragma unroll
    for (int blk = 0; blk < 2; ++blk) { float fa[8], fb[8]; unpack8(__builtin_bit_cast(u32x4, qr[8 + 2 * blk]), fa); unpack8(__builtin_bit_cast(u32x4, qr[9 + 2 * blk]), fb);
      const float* ga = qkg + 128 + 32 * blk + hi8; const int pos = blk == 0 ? (t_ >> 6) : (t_ & 63);
      const float* tc = tab + (blk == 0 ? T_MC_R : T_MC_C) + pos * 16 + hi8; const float* ts = tab + (blk == 0 ? T_MS_R : T_MS_C) + pos * 16 + hi8;
      const f32x4 gA[2] = {((const f32x4*)ga)[0], ((const f32x4*)ga)[1]}, gB[2] = {((const f32x4*)(ga + 16))[0], ((const f32x4*)(ga + 16))[1]};
      const f32x4 cv[2] = {((const f32x4*)tc)[0], ((const f32x4*)tc)[1]}, sv[2] = {((const f32x4*)ts)[0], ((const f32x4*)ts)[1]};
#pragma unroll
      for (int e = 0; e < 8; ++e) { const float ya = fa[e] * rr * (gA[e >> 2][e & 3] * qscale), yb = fb[e] * rr * (gB[e >> 2][e & 3] * qscale);
        const float cs = isl ? cv[e >> 2][e & 3] : 1.f, sn = isl ? sv[e >> 2][e & 3] : 0.f;
        fa[e] = ya * cs - yb * sn; fb[e] = ya * sn + yb * cs; }
      qr[8 + 2 * blk] = __builtin_bit_cast(bf16x8, pack8(fa)); qr[9 + 2 * blk] = __builtin_bit_cast(bf16x8, pack8(fb)); }
  }
  if constexpr (QP == 2) {
    int hi8 = hi * 8; asm volatile("" : "+v"(hi8));
    float ss_ = 0.f;
#pragma unroll
    for (int d0 = 0; d0 < 8; ++d0) { float f[8]; unpack8(__builtin_bit_cast(u32x4, qr[d0]), f);
#pragma unroll
      for (int e = 0; e < 8; ++e) ss_ += f[e] * f[e]; }
    { auto r0_ = __builtin_amdgcn_permlane32_swap(__float_as_uint(ss_), __float_as_uint(ss_), false, false); ss_ = __uint_as_float(r0_[0]) + __uint_as_float(r0_[1]); }
    const float rn = frsq(ss_ * (1.f / 128.f) + EPS);
    const int t_ = (qrow0 + wid * QBLK + r32) & (SEQ - 1);
#pragma unroll
    for (int blk = 0; blk < 2; ++blk) { const int pos = blk == 0 ? (t_ >> 6) : (t_ & 63);
#pragma unroll
      for (int dd = 0; dd < 2; ++dd) { float fa[8], fb[8]; unpack8(__builtin_bit_cast(u32x4, qr[4 * blk + dd]), fa); unpack8(__builtin_bit_cast(u32x4, qr[4 * blk + 2 + dd]), fb);
        const float* ga = qkg + 64 * blk + 16 * dd + hi8; const float* tc = tab + (blk == 0 ? T_SC_R : T_SC_C) + pos * 32 + 16 * dd + hi8; const float* ts = tab + (blk == 0 ? T_SS_R : T_SS_C) + pos * 32 + 16 * dd + hi8;
        const f32x4 gA[2] = {((const f32x4*)ga)[0], ((const f32x4*)ga)[1]}, gB[2] = {((const f32x4*)(ga + 32))[0], ((const f32x4*)(ga + 32))[1]};
        const f32x4 cv[2] = {((const f32x4*)tc)[0], ((const f32x4*)tc)[1]}, sv[2] = {((const f32x4*)ts)[0], ((const f32x4*)ts)[1]};
#pragma unroll
        for (int e = 0; e < 8; ++e) { const float ya = fa[e] * rn * gA[e >> 2][e & 3], yb = fb[e] * rn * gB[e >> 2][e & 3]; const float cs = cv[e >> 2][e & 3], sn = sv[e >> 2][e & 3]; fa[e] = ya * cs - yb * sn; fb[e] = ya * sn + yb * cs; }
        qr[4 * blk + dd] = __builtin_bit_cast(bf16x8, pack8(fa)); qr[4 * blk + 2 + dd] = __builtin_bit_cast(bf16x8, pack8(fb)); } }
  }
  f32x16 p0, p1; float mn, al; bf16x8 pa0, pa1, pa2, pa3;
  ATT_SWRITE(0); if (EARLY && 1 < NT) ATT_SLOAD(1); __syncthreads();
  for (int t = 0; t < NT; ++t) {
    const int bsel = t & 1;
    ATT_SBAR();
    qkt<DQK>(p0, p1, K_lds + bsel * SHM_K, qr, r32, hi); maskt<MODE>(p0, p1, t, band0, qpos, hi);
    partialSM(p0, p1, m_reg, mn, al, C, thr, fixref); finishSM(p0, p1, al, l_reg, pa0, pa1, pa2, pa3);
    if (__any(al < 1.f)) { if (hi == 0) al_l[r32] = al; asm volatile("s_waitcnt lgkmcnt(0)" ::: "memory");
#pragma unroll
      for (int d = 0; d < 4; ++d)
#pragma unroll
        for (int r = 0; r < 16; ++r) o[d][r] *= al_l[crow(r, hi)]; }
    ATT_SBAR();
    if (!EARLY && t + 1 < NT) ATT_SLOAD(t + 1);
    if (EARLY && t + 1 < NT) { ATT_SWRITE(bsel ^ 1); if (t + 2 < NT) ATT_SLOAD(t + 2); }
    ATT_SBAR();
    pv_d0(o, vb0 + bsel * SHM_V, pa0, pa1, pa2, pa3);
    if (!EARLY && t + 1 < NT) ATT_SWRITE(bsel ^ 1);
    __syncthreads();
  }
  if (MODE == 1) l_reg += __builtin_amdgcn_exp2f(sinkL2 - (fixref > 0.f ? 0.f : m_reg * C));
  if (hi == 0) li_l[r32] = l_reg; asm volatile("s_waitcnt lgkmcnt(0)" ::: "memory");
  float rli[16];
#pragma unroll
  for (int r = 0; r < 16; ++r) rli[r] = __builtin_amdgcn_rcpf(li_l[crow(r, hi)]);
  bf16* Ow = Ob + (long)(wid * QBLK) * ldo;
  {
    char* Ost = lds + wid * 8192;
#pragma unroll
    for (int r = 0; r < 16; ++r) { const int orow = crow(r, hi);
#pragma unroll
      for (int d0 = 0; d0 < 4; ++d0) *(unsigned short*)(Ost + orow * 256 + (d0 * 32 + r32) * 2) = f2bf(o[d0][r] * rli[r]); }
    asm volatile("s_waitcnt lgkmcnt(0)" ::: "memory");
#pragma unroll
    for (int k = 0; k < 8; ++k) { const int pc = k * 64 + lane, row = pc >> 4, c = pc & 15;
      *(u32x4*)(Ow + (long)row * ldo + c * 8) = *(const u32x4*)(Ost + row * 256 + c * 16); }
  }
  __syncthreads();
#undef ATT_TROW
#undef ATT_SLOAD
#undef ATT_SWRITE
}
}

struct Args { const float* in[N_IN]; float* out; unsigned char* ws; int ph_lo, ph_hi; };
#ifdef PROBE_MODE
constexpr int N_PHASES = 40;
#else
constexpr int N_PHASES = 39;
#endif

__global__ void __launch_bounds__(NTHR, 2) fwd_kernel(Args args) {
    extern __shared__ __attribute__((aligned(16))) unsigned char lds_raw[];
    LAS unsigned char* lds = (LAS unsigned char*)lds_raw;
#define tid ((int)threadIdx.x)
#define lane ((int)(threadIdx.x & 63))
#define wave (__builtin_amdgcn_readfirstlane((int)(threadIdx.x >> 6)))
#define G ((int)gridDim.x)
#define bid ((int)blockIdx.x)
#define gw (bid * NWAVES + wave)
#define NGW (G * NWAVES)
#define gt (bid * NTHR + tid)
#define NGT (G * NTHR)
    unsigned char* ws = args.ws; const float* const* in = args.in;
    volatile LAS unsigned* MISC = (volatile LAS unsigned*)(lds + MISC_OFF);
    for (int u = tid; u < (LDS_BYTES - MISC_OFF) / 4; u += NTHR) ((LAS unsigned*)(lds + MISC_OFF))[u] = 0u;
    __syncthreads();
    const int lo = args.ph_lo, hi = args.ph_hi;
    const bool one_launch = (hi - lo) > 1;
    XcdBarrier bar; bar.bar = (unsigned*)(ws + WS_CTL) + CW_BAR; bar.x = 0; bar.st = MISC + 8;
    if (one_launch) bar = xcd_barrier_post((unsigned*)(ws + WS_CTL) + CW_BAR, MISC + 8);
#ifndef ONLY
#define ONLY -1
#endif
#define IN(k) ((ONLY < 0 || ONLY == (k)) && lo <= (k) && (k) < hi)
#ifndef DUP_MASK
#define DUP_MASK(k) 0
#endif
#define REP(k) for (int rep_ = 0; rep_ < 1 + (DUP_MASK(k)); ++rep_)
#define SEAM(k) do { if (IN(k) && IN((k) + 1)) xcd_barrier(bar); } while (0)
    float* xlat = args.out; float* xctx = (float*)(ws + WS_XC);
    const float* modv = (const float*)(ws + WS_MODV); const float* tab = (const float*)(ws + WS_TAB);
    bf16* Hb = (bf16*)(ws + WS_H);
    bf16* HID = (bf16*)(ws + B_HID);
#define scr ((LAS float*)(lds + wave * 16384))

#ifndef PG_ALIGN
#define PG_ALIGN true
#endif
#ifndef PG_SP2
#define PG_SP2 true
#endif
#define GEMM_STORE(Aptr, Wptr, Mr, Nn, Kk, Optr, ldc_, splitc, splits) GEMM_STORE_C(Aptr, Wptr, Mr, Nn, Kk, Optr, ldc_, splitc, splits, bid)
#define GEMM_STORE_C(Aptr, Wptr, Mr, Nn, Kk, Optr, ldc_, splitc, splits, cc_) do { pg8::Gemm g_{(const pg8::bf16_t*)(Aptr), (const pg8::bf16_t*)(Wptr), (Mr), (Nn), (Kk), (Kk)}; pg8::StaticOrder S_; S_.init((Mr), (Nn), G, (cc_), WGM_ST); \
        pg8::EpiBf16<0> E_{(pg8::bf16_t*)(Optr), (ldc_), nullptr, (splitc), (splits), 1.f}; pg8::gemm_phase<pg8::EpiBf16<0>, pg8::StaticOrder, PG_ALIGN, PG_SP2>(lds, g_, S_, E_); } while (0)
#define GEMM_RESID(Aptr, Wptr, Mr, Kk, srcl, layer, chunk, ksplit) do { \
        if ((Mr) > MLAT) { pg8::Gemm g_{(const pg8::bf16_t*)(Aptr), (const pg8::bf16_t*)(Wptr), MROWS, DM, (Kk) / (ksplit), (Kk)}; pg8::CtxSplitOrder S_{(ksplit), (Kk) / (ksplit), G, bid}; \
        pg8::EpiPartial E_{(float*)(ws + B_PART), (Kk) / (ksplit)}; pg8::gemm_phase<pg8::EpiPartial, pg8::CtxSplitOrder, PG_ALIGN, PG_SP2>(lds, g_, S_, E_); } \
        { pg8::Gemm g_{(const pg8::bf16_t*)(Aptr), (const pg8::bf16_t*)(Wptr), MLAT, DM, (Kk), (Kk)}; pg8::StaticOrder S_; S_.init(MLAT, DM, G, bid, WGM_RES, 0, (Kk) == FFH); \
        pg8::EpiResid E_{(srcl), xctx, xlat, xctx, modv + (size_t)(layer) * 3 * 12288 + (chunk) * DM}; pg8::gemm_phase<pg8::EpiResid, pg8::StaticOrder, PG_ALIGN, PG_SP2>(lds, g_, S_, E_); } } while (0)
#ifndef WGM_RES
#define WGM_RES 4
#endif
#ifndef WGM_ST
#define WGM_ST 4
#endif
#ifndef WGM_FUP
#define WGM_FUP 4
#endif
#define FFN_UP(Mr) do { pg8::Gemm g_{(const pg8::bf16_t*)Hb, (const pg8::bf16_t*)(ws + W_FUP), (Mr), 2 * FFH, DM, DM}; pg8::StaticOrder S_; S_.init((Mr), 2 * FFH, G, bid, WGM_FUP); \
        pg8::EpiSwiglu E_{(pg8::bf16_t*)HID, FFH}; pg8::gemm_phase<pg8::EpiSwiglu, pg8::StaticOrder, PG_ALIGN, PG_SP2>(lds, g_, S_, E_); } while (0)
#define NORM(srcl, srcc, layer, which, Mr, ns, pl, pch) norm_phase((srcl), (srcc), in[I_NORMG] + ((layer) * 2 + (which)) * DM, modv + (size_t)(layer) * 3 * 12288, (which), Hb, (Mr), gw, NGW, lane, \
        (ns) ? (const float*)(ws + B_PART) : nullptr, (ns), modv + (size_t)(pl) * 3 * 12288 + 2 * 12288 + (pch) * DM, xctx)

    if (IN(0)) REP(0) { prologue(in, ws, lds, bid, G, tid); } SEAM(0);
    if (IN(1)) REP(1) { NORM(in[I_X], in[I_CTX], 0, 0, MROWS, 0, 0, 0); } SEAM(1);
    if (IN(2)) REP(2) { GEMM_STORE(Hb, ws + W_RGWI, MROWS, 4096, DM, ws + B_GR, 4096, 0, 0); } SEAM(2);
    if (IN(3)) REP(3) { rglru_items<1>((const bf16*)(ws + B_GR), in[I_RGCW], in[I_RGCB], (const bf16*)(ws + W_RGG), in[I_RGGB], in[I_RGLAM], (float*)(ws + B_CARRY), nullptr, nullptr, lds, bid, G, tid); } SEAM(3);
    if (IN(4)) REP(4) { rglru_prop((const float*)(ws + B_CARRY), (float*)(ws + B_HIN), (LAS float*)lds, bid, G, tid); } SEAM(4);
    if (IN(5)) REP(5) { rglru_items<2>((const bf16*)(ws + B_GR), in[I_RGCW], in[I_RGCB], (const bf16*)(ws + W_RGG), in[I_RGGB], in[I_RGLAM], nullptr, (const float*)(ws + B_HIN), Hb, lds, bid, G, tid); } SEAM(5);
    if (IN(6)) { GEMM_RESID(Hb, ws + W_RGWO, MROWS, DM, in[I_X], 0, 2, 8); } SEAM(6);
    if (IN(7)) REP(7) { NORM(xlat, in[I_CTX], 0, 1, MROWS, 8, 0, 2); } SEAM(7);
    if (IN(8)) REP(8) { FFN_UP(MROWS); } SEAM(8);
    if (IN(9)) { GEMM_RESID(HID, ws + W_FDN, MROWS, FFH, xlat, 0, 5, 11); } SEAM(9);
    if (IN(10)) REP(10) { NORM(xlat, xctx, 1, 0, MROWS, 11, 0, 5); __syncthreads(); cvt_ffn(in[I_FFNWI], in[I_FFNWO], 1, ws, scr, gw, NGW, lane); } SEAM(10);
    if (IN(11)) REP(11) { GEMM_STORE(Hb, ws + W_HGWI, MROWS, 10240, DM, ws + B_HG, DM, DM, (size_t)MROWS * DM); } SEAM(11);
    if (IN(12)) REP(12) { gla_items<1>((const bf16*)(ws + B_HG), tab + T_LB, (float*)(ws + B_ST), (float*)(ws + B_DV), nullptr, nullptr, lds, bid, G, tid); } SEAM(12);
    if (IN(13)) { gla_prop((float*)(ws + B_ST), (const float*)(ws + B_DV), gt, NGT); } SEAM(13);
    if (IN(14)) REP(14) { gla_items<2>((const bf16*)(ws + B_HG), tab + T_LB, (float*)(ws + B_ST), (float*)(ws + B_DV), (bf16*)(ws + B_OF), (bf16*)(ws + B_OB), lds, bid, G, tid); } SEAM(14);
    if (IN(15)) REP(15) { gla_final((const bf16*)(ws + B_OF), (const bf16*)(ws + B_OB), (const bf16*)(ws + B_HG) + 4 * (size_t)MROWS * DM, in[I_HGGN], Hb, gw, NGW, lane); } SEAM(15);
    if (IN(16)) { GEMM_RESID(Hb, ws + W_HGWO, MROWS, DM, xlat, 1, 2, 8); } SEAM(16);
    if (IN(17)) REP(17) { NORM(xlat, xctx, 1, 1, MROWS, 8, 1, 2); } SEAM(17);
    if (IN(18)) REP(18) { FFN_UP(MROWS); } SEAM(18);
    if (IN(19)) { GEMM_RESID(HID, ws + W_FDN, MROWS, FFH, xlat, 1, 5, 11); } SEAM(19);
    if (IN(20)) REP(20) { NORM(xlat, xctx, 2, 0, MROWS, 11, 1, 5); __syncthreads(); cvt_ffn(in[I_FFNWI], in[I_FFNWO], 2, ws, scr, gw, NGW, lane); } SEAM(20);
    if (IN(21)) REP(21) { GEMM_STORE(Hb, ws + W_MLWI, MROWS, 1280, DM, ws + B_MLC, 1280, 0, 0); } SEAM(21);
    if (IN(22)) REP(22) { mla_prep1((const bf16*)(ws + B_MLC), in[I_MLQN], in[I_MLKVN], in[I_MLQKG], tab, (bf16*)(ws + B_CQN), (bf16*)(ws + B_CKVN), (bf16*)(ws + B_KR), gw, NGW, lane); } SEAM(22);
    if (IN(23)) REP(23) { GEMM_STORE(ws + B_CQN, ws + W_MLUQ, MROWS, 3072, 512, ws + B_Q, 3072, 0, 0); }
    if (IN(24)) REP(24) { GEMM_STORE_C(ws + B_CKVN, ws + W_MLUKV, MROWS, 4096, 512, ws + B_KV, 4096, 0, 0, (G & 15) == 0 ? (bid + G / 2) % G : bid); } SEAM(24);
    if (IN(25)) { mla_prep2((bf16*)(ws + B_Q), (const bf16*)(ws + B_KV), (const bf16*)(ws + B_KR), (bf16*)(ws + B_KN), in[I_MLQKG], tab, gw, NGW, lane, tab[T_MFIX] > 0.f ? 0.07216878364870322f * LOG2E : 1.f); } SEAM(25);
    if (IN(26)) REP(26) {
        const bf16* Q = (const bf16*)(ws + B_Q); const bf16* KN = (const bf16*)(ws + B_KN); const bf16* KV = (const bf16*)(ws + B_KV);
        const int nu = 2048 + 32;
        for (int i = 0; bid + i * G < nu; ++i) {
            const int u = bid + i * G; int bh, qb, NT, row0;
            if (u < 2048) { if (G == 256) { bh = (bid & 7) + 8 * (i >> 1); qb = (i & 1) * 32 + (bid >> 3); } else { bh = u >> 6; qb = u & 63; } NT = 260; row0 = (bh >> 4) * SEQ + qb * 256; }
            else { bh = u - 2048; NT = 4; row0 = MLAT + (bh >> 4) * CTXL; }
            const int b = bh >> 4, h = bh & 15;
            att::attn_unit_simple<192, 0, true, 1>(Q + (size_t)row0 * 3072 + h * 192, 3072, KN + h * 192, 3072, KV + h * 256 + 128, 4096, Hb + (size_t)row0 * DM + h * 128, DM, NT, MLAT + b * CTXL, b * SEQ, 0, 0, 0.07216878364870322f, 0.f, (char*)lds_raw, tab[T_MFIX],
                in[I_MLQKG], tab, tab[T_MFIX] > 0.f ? 0.07216878364870322f * LOG2E : 1.f, row0);
        }
    } SEAM(26);
    if (IN(27)) { GEMM_RESID(Hb, ws + W_MLWO, MROWS, DM, xlat, 2, 2, 8); } SEAM(27);
    if (IN(28)) REP(28) { NORM(xlat, xctx, 2, 1, MROWS, 8, 2, 2); } SEAM(28);
    if (IN(29)) REP(29) { FFN_UP(MROWS); } SEAM(29);
    if (IN(30)) { GEMM_RESID(HID, ws + W_FDN, MROWS, FFH, xlat, 2, 5, 11); } SEAM(30);
#ifdef JUNK_THIN
    if (IN(31)) {
        if (JUNK_THIN & 1) mla_prep2((bf16*)(ws + B_Q), (const bf16*)(ws + B_KV), (const bf16*)(ws + B_KR), (bf16*)(ws + B_KN), in[I_MLQKG], tab, gw, NGW, lane, tab[T_MFIX] > 0.f ? 0.07216878364870322f * LOG2E : 1.f);
        if (JUNK_THIN & 2) swa_prep((bf16*)(ws + B_KV), in[I_SWQKG], tab, gw, NGW, lane);
        if (JUNK_THIN & 4) gla_prop((float*)(ws + B_ST), (const float*)(ws + B_DV), gt, NGT);
        xcd_barrier(bar);
    }
#endif
    if (IN(31)) REP(31) { NORM(xlat, xctx, 3, 0, MROWS, 11, 2, 5); __syncthreads(); cvt_ffn(in[I_FFNWI], in[I_FFNWO], 3, ws, scr, gw, NGW, lane); } SEAM(31);
    if (IN(32)) REP(32) { GEMM_STORE(Hb, ws + W_SWWI, MROWS, 3072, DM, ws + B_QKV, 3072, 0, 0); } SEAM(32);
    if (IN(33)) { swa_prep((bf16*)(ws + B_QKV), in[I_SWQKG], tab, gw, NGW, lane); } SEAM(33);
    if (IN(34)) REP(34) {
        const bf16* QKV = (const bf16*)(ws + B_QKV);
        for (int u = bid; u < 2048; u += G) { const int b = u >> 10, h = (u >> 6) & 15, qb = u & 63, kvh = h >> 2; const int row0 = b * SEQ + qb * 256;
            att::attn_unit_simple<128, 1, true, 2>(QKV + (size_t)row0 * 3072 + h * 128, 3072, QKV + 2048 + kvh * 128, 3072, QKV + 2560 + kvh * 128, 3072, Hb + (size_t)row0 * DM + h * 128, DM, 12, MLAT + b * CTXL, b * SEQ, qb * 256 - 128, qb * 256,
                                   0.08838834764831845f, in[I_SWSINK][h] * LOG2E, (char*)lds_raw, 0.f, in[I_SWQKG], tab, 1.f, row0); }
    } SEAM(34);
    if (IN(35)) { GEMM_RESID(Hb, ws + W_SWWO, MLAT, DM, xlat, 3, 2, 8); } SEAM(35);
    if (IN(36)) REP(36) { NORM(xlat, xctx, 3, 1, MLAT, 0, 0, 0); } SEAM(36);
    if (IN(37)) REP(37) { FFN_UP(MLAT); } SEAM(37);
    if (IN(38)) { GEMM_RESID(HID, ws + W_FDN, MLAT, FFH, xlat, 3, 5, 11); } SEAM(38);
#ifdef EXTRA_BARRIERS
    if (IN(38)) { for (int xb_ = 0; xb_ < EXTRA_BARRIERS; ++xb_) xcd_barrier(bar); }
#endif
#ifdef JUNK_GEMM
    {
        float* jl = (float*)(ws + WS_BIG + 400 * MiB); float* jc = jl + (size_t)MLAT * DM;
        { xcd_barrier(bar); pg8::Gemm g_{(const pg8::bf16_t*)(JUNK_A), (const pg8::bf16_t*)(JUNK_W), MROWS, DM, JUNK_K, JUNK_K}; pg8::StaticOrder S_; S_.init(MROWS, DM, G, bid);
            pg8::EpiResid E_{jl, jc, jl, jc, modv}; pg8::gemm_phase<pg8::EpiResid, pg8::StaticOrder, PG_ALIGN, PG_SP2>(lds, g_, S_, E_); }
    }
#endif
#ifdef PROBE_MODE
    if (IN(39)) {
        for (size_t i = gt; i < (size_t)MLAT * DM / 4; i += NGT) { const int row = (int)(i >> 9), c4 = (int)(i & 511) * 4; f32x4 v = ((f32x4*)xlat)[i];
            { const float d0 = PROBE_D(row, c4 + 0), d1 = PROBE_D(row, c4 + 1), d2 = PROBE_D(row, c4 + 2), d3 = PROBE_D(row, c4 + 3); v.x += d0; v.y += d1; v.z += d2; v.w += d3; }
            ((f32x4*)xlat)[i] = v; }
    }
#endif
#undef IN
#undef SEAM
#undef tid
#undef lane
#undef wave
#undef G
#undef bid
#undef gw
#undef NGW
#undef gt
#undef NGT
}

#ifndef MK_N_LAUNCHES
#define MK_N_LAUNCHES 1
#endif
extern "C" void kernel_launch(void* const* d_in, const int* in_sizes, int n_in, void* d_out, int out_size, void* d_ws, size_t ws_size, hipStream_t stream) {
    static int grid = 0;
    if (grid == 0) {
        if (n_in != N_IN || out_size != MLAT * DM || ws_size < (size_t)1532 * MiB) { fprintf(stderr, "kernel_launch: unexpected shapes: n_in %d out %d ws %zu (need %zu)\n", n_in, out_size, ws_size, (size_t)WS_END); grid = -1; return; }
        int dev = 0, cus = 0, per_cu = 0;
        if (hipGetDevice(&dev) != hipSuccess || hipDeviceGetAttribute(&cus, hipDeviceAttributeMultiprocessorCount, dev) != hipSuccess) { grid = -1; return; }
        if (hipFuncSetAttribute((const void*)fwd_kernel, hipFuncAttributeMaxDynamicSharedMemorySize, LDS_BYTES) != hipSuccess) { fprintf(stderr, "kernel_launch: hipFuncSetAttribute failed\n"); grid = -1; return; }
        if (hipOccupancyMaxActiveBlocksPerMultiprocessor(&per_cu, (const void*)fwd_kernel, NTHR, LDS_BYTES) != hipSuccess || per_cu < 1) fprintf(stderr, "kernel_launch: occupancy query reports %d\n", per_cu);
        (void)hipGetLastError();
        grid = cus;
    }
    if (grid < 0) return;
    if (hipMemsetAsync((char*)d_ws + WS_CTL, 0, CTL_ZERO_BYTES, stream) != hipSuccess) return;
    Args a{};
    for (int i = 0; i < N_IN; ++i) a.in[i] = (const float*)d_in[i];
    a.out = (float*)d_out; a.ws = (unsigned char*)d_ws;
    if (MK_N_LAUNCHES == 1) { a.ph_lo = 0; a.ph_hi = N_PHASES; hipLaunchKernelGGL(fwd_kernel, dim3(grid), dim3(NTHR), LDS_BYTES, stream, a); }
    else { for (int p = 0; p < N_PHASES; ++p) { a.ph_lo = p; a.ph_hi = p + 1; hipLaunchKernelGGL(fwd_kernel, dim3(grid), dim3(NTHR), LDS_BYTES, stream, a); } }
    const hipError_t le = hipPeekAtLastError();
    if (le != hipSuccess) fprintf(stderr, "kernel_launch: launch failed: %s\n", hipGetErrorName(le));
}
```

```cpp
#include <hip/hip_runtime.h>
#include <cstdio>
#include <cstdint>
namespace pg8 {
#define PG8_LAS __attribute__((address_space(3)))
typedef unsigned short bf16_t;
typedef short bf16x8 __attribute__((ext_vector_type(8)));
typedef float f32x4 __attribute__((ext_vector_type(4)));
typedef unsigned u32x4 __attribute__((ext_vector_type(4)));
constexpr int BM = 256, BK = 64, HALF = 128, HTB = HALF * BK * 2  , STAGE_BYTES = 8 * HTB, NXCD = 8;

__host__ __device__ __forceinline__ int lds_byte(int r, int c) { const int st = (r >> 4) * 2 + (c >> 5), rr = r & 15, cc = c & 31, ob = rr * 64 + cc * 2; return st * 1024 + (ob ^ (((ob >> 9) & 1) << 5)); }
__host__ __device__ __forceinline__ void stage_rc(int b, int& R, int& C) { const int st = b / 1024, sb = b % 1024, swz = sb ^ (((sb >> 9) & 1) << 5); R = (st >> 1) * 16 + swz / 64; C = (st & 1) * 32 + (swz % 64) / 2; }
__host__ __device__ __forceinline__ int perm32(int rho) { const int n = rho >> 4, i = rho & 15; return 8 * (i >> 2) + 4 * n + (i & 3); }

struct Unit { int pm, pn, ko; };
struct Gemm { const bf16_t* A; const bf16_t* Bt; int M, N, K, ld; };

struct StaticOrder {
    int nM, nN, nwg, G, c, WGM, pm0, rev;
    __host__ __device__ void init(int M, int N, int G_, int c_, int wgm_ = 4, int pm0_ = 0, int rev_ = 0) { nM = M / BM; nN = N / BM; nwg = nM * nN; G = G_; c = c_; WGM = wgm_; pm0 = pm0_; rev = rev_; }
    __host__ __device__ bool next(int i, Unit& u) const {
        const long L = (long)i * G + c; if (L >= nwg) return false;
        int wgid = (int)L; { const int q = nwg / NXCD, r = nwg % NXCD, xcd = wgid % NXCD; int off = wgid / NXCD; if (rev) off = (xcd < r ? q : q - 1) - off; wgid = (xcd < r ? xcd * (q + 1) : r * (q + 1) + (xcd - r) * q) + off; }
        const int nig = WGM * nN, gid = wgid / nig, fm = gid * WGM, gsz = (nM - fm) < WGM ? (nM - fm) : WGM;
        u.pm = pm0 + fm + ((wgid % nig) % gsz); u.pn = (wgid % nig) / gsz; u.ko = 0; return true;
    }
    __device__ __forceinline__ void a_ready(const Unit&) const {}
    __device__ __forceinline__ void done(const Unit&) const {}
};

__device__ __forceinline__ unsigned cvt_pk_bf16(float lo, float hi) { unsigned r; asm volatile("v_cvt_pk_bf16_f32 %0, %1, %2" : "=v"(r) : "v"(lo), "v"(hi)); return r; }
typedef float f32x2 __attribute__((ext_vector_type(2)));
__device__ __forceinline__ f32x2 gelu_pk(f32x2 v) {
    const f32x2 av = __builtin_elementwise_abs(v), d = av * 0.2316418882f + 1.0f;
    f32x2 t; t.x = __builtin_amdgcn_rcpf(d.x); t.y = __builtin_amdgcn_rcpf(d.y);
    f32x2 q = t * 0.5307027145f + (-0.7265760135f); q = q * t + 0.7107068705f; q = q * t + (-0.142248368f); q = q * t + 0.127414796f; q = q * t;
    const f32x2 s = (v * v) * (-0.72134752044f);
    f32x2 e; e.x = __builtin_amdgcn_exp2f(s.x); e.y = __builtin_amdgcn_exp2f(s.y);
    const f32x2 m = v * (q * e), r = v - m;
    f32x2 o; o.x = v.x < 0.f ? m.x : r.x; o.y = v.y < 0.f ? m.y : r.y; return o;
}

template <int ACT  > struct EpiBf16 {
    static constexpr bool PERM = true, AFTER_DRAIN = false; static_assert(ACT == 0 || ACT == 1, "EpiBf16: ACT is 0 (none) or 1 (gelu_pk)");
    bf16_t* O; int ldc; const float* bias; int split_cols; size_t split_stride; float scale0;
    __device__ __forceinline__ void operator()(const f32x4 (&acc)[2][2][4][2], const Unit& u, int wr, int wc, int fr, int fq) const {
        const int row0 = u.pm * BM + wr * 64 + fr; int colt = u.pn * BM; bf16_t* base = O;
        float sc = 1.f; if (split_cols) { const int t = colt / split_cols; base += (size_t)t * split_stride; colt -= t * split_cols; if (t == 0) sc = scale0; }
        const int col0 = colt + wc * 32 + 8 * fq, bcol0 = u.pn * BM + wc * 32 + 8 * fq;
        f32x4 bv[2][2];
#pragma unroll
        for (int bj = 0; bj < 2; ++bj)
#pragma unroll
            for (int n = 0; n < 2; ++n) bv[bj][n] = bias ? *(const f32x4*)(bias + bcol0 + bj * HALF + 4 * n) : (f32x4){0.f, 0.f, 0.f, 0.f};
#pragma unroll
        for (int ai = 0; ai < 2; ++ai)
#pragma unroll
            for (int m = 0; m < 4; ++m) { bf16_t* rowp = base + (size_t)(row0 + ai * HALF + m * 16) * ldc + col0;
#pragma unroll
                for (int bj = 0; bj < 2; ++bj) { f32x4 v0 = acc[ai][bj][m][0] + bv[bj][0], v1 = acc[ai][bj][m][1] + bv[bj][1];
                    if (ACT == 1) { f32x2 a = gelu_pk((f32x2){v0[0], v0[1]}), b = gelu_pk((f32x2){v0[2], v0[3]}), c = gelu_pk((f32x2){v1[0], v1[1]}), d = gelu_pk((f32x2){v1[2], v1[3]});
                        v0 = (f32x4){a.x, a.y, b.x, b.y}; v1 = (f32x4){c.x, c.y, d.x, d.y}; }
                    v0 = v0 * sc; v1 = v1 * sc; u32x4 w; w.x = cvt_pk_bf16(v0[0], v0[1]); w.y = cvt_pk_bf16(v0[2], v0[3]); w.z = cvt_pk_bf16(v1[0], v1[1]); w.w = cvt_pk_bf16(v1[2], v1[3]);
                    *(u32x4*)(rowp + bj * HALF) = w; } }
    }
};
struct EpiSwiglu {
    static constexpr bool PERM = true, AFTER_DRAIN = false;
    bf16_t* O; int ldc;
    __device__ __forceinline__ void operator()(const f32x4 (&acc)[2][2][4][2], const Unit& u, int wr, int wc, int fr, int fq) const {
        const int row0 = u.pm * BM + wr * 64 + fr; const int col0 = u.pn * HALF + wc * 32 + 8 * fq;
#pragma unroll
        for (int ai = 0; ai < 2; ++ai)
#pragma unroll
            for (int m = 0; m < 4; ++m) { bf16_t* rowp = O + (size_t)(row0 + ai * HALF + m * 16) * ldc + col0;
                float h[8];
#pragma unroll
                for (int n = 0; n < 2; ++n)
#pragma unroll
                    for (int e = 0; e < 4; ++e) { const float g = acc[ai][0][m][n][e], up = acc[ai][1][m][n][e];
                        h[n * 4 + e] = g * __builtin_amdgcn_rcpf(1.f + __builtin_amdgcn_exp2f(-1.4426950408889634f * g)) * up; }
                u32x4 w; w.x = cvt_pk_bf16(h[0], h[1]); w.y = cvt_pk_bf16(h[2], h[3]); w.z = cvt_pk_bf16(h[4], h[5]); w.w = cvt_pk_bf16(h[6], h[7]);
                *(u32x4*)rowp = w; }
    }
};
struct EpiResid {
    static constexpr bool PERM = false, AFTER_DRAIN = false;
    const float* src_lat; const float* src_ctx; float* dst_lat; float* dst_ctx; const float* gate;
    __device__ __forceinline__ void operator()(const f32x4 (&acc)[2][2][4][2], const Unit& u, int wr, int wc, int fr, int fq) const {
        const int r0 = u.pm * BM; const bool isl = r0 < 32768; const int ci = isl ? (r0 >> 14) : 2;
        const float* sp = isl ? src_lat + (size_t)r0 * 2048 : src_ctx + (size_t)(r0 - 32768) * 2048;
        float* dp = isl ? dst_lat + (size_t)r0 * 2048 : dst_ctx + (size_t)(r0 - 32768) * 2048;
        const float* gp = gate + ci * 12288;
        const int col0 = u.pn * BM + wc * 32 + 4 * fq;
        f32x4 gv[2][2];
#pragma unroll
        for (int bj = 0; bj < 2; ++bj)
#pragma unroll
            for (int n = 0; n < 2; ++n) gv[bj][n] = *(const f32x4*)(gp + col0 + bj * HALF + n * 16);
#pragma unroll
        for (int ai = 0; ai < 2; ++ai)
#pragma unroll
            for (int m = 0; m < 4; ++m) { const size_t off = (size_t)(wr * 64 + ai * HALF + m * 16 + fr) * 2048 + col0;
                f32x4 xv[2][2];
#pragma unroll
                for (int bj = 0; bj < 2; ++bj)
#pragma unroll
                    for (int n = 0; n < 2; ++n) xv[bj][n] = *(const f32x4*)(sp + off + bj * HALF + n * 16);
#pragma unroll
                for (int bj = 0; bj < 2; ++bj)
#pragma unroll
                    for (int n = 0; n < 2; ++n) *(f32x4*)(dp + off + bj * HALF + n * 16) = xv[bj][n] + gv[bj][n] * acc[ai][bj][m][n];
                if (m & 1) asm volatile("" ::: "memory"); }
    }
};

struct CtxSplitOrder {
    int S, klen, G, c;
    __device__ bool next(int i, Unit& u) const { const int L = i * G + c; if (L >= 16 * S) return false; const int t = L / S, kq = L - t * S; u.pm = 128 + (t >> 3); u.pn = t & 7; u.ko = kq * klen; return true; }
    __device__ __forceinline__ void a_ready(const Unit&) const {}
    __device__ __forceinline__ void done(const Unit&) const {}
};
struct EpiPartial {
    static constexpr bool PERM = false, AFTER_DRAIN = false;
    float* part; int klen;
    __device__ __forceinline__ void operator()(const f32x4 (&acc)[2][2][4][2], const Unit& u, int wr, int wc, int fr, int fq) const {
        float* dp = part + ((size_t)(u.ko / klen) * 512 + (size_t)(u.pm - 128) * BM) * 2048;
        const int col0 = u.pn * BM + wc * 32 + 4 * fq;
#pragma unroll
        for (int ai = 0; ai < 2; ++ai)
#pragma unroll
            for (int m = 0; m < 4; ++m) { const size_t off = (size_t)(wr * 64 + ai * HALF + m * 16 + fr) * 2048 + col0;
#pragma unroll
                for (int bj = 0; bj < 2; ++bj)
#pragma unroll
                    for (int n = 0; n < 2; ++n) *(f32x4*)(dp + off + bj * HALF + n * 16) = acc[ai][bj][m][n]; }
    }
};

template <class Epi, class Sched, bool ALIGN_EPI = false, bool SP2 = false>
__device__ __forceinline__ void gemm_phase(PG8_LAS unsigned char* lds, const Gemm g, const Sched& S, const Epi& E) {
    int tid_ = threadIdx.x; asm volatile("" : "+v"(tid_));
    const int tid = tid_, wid = __builtin_amdgcn_readfirstlane(tid >> 6), lane = tid & 63, wr = wid >> 2, wc = wid & 3, fr = lane & 15, fq = lane >> 4;
    const int K = g.ld, nt = g.K / BK;
    unsigned voffA[2], voffB[2];
#pragma unroll
    for (int i = 0; i < 2; ++i) { int R, C; stage_rc(tid * 16 + i * 8192, R, C); const int Rb = Epi::PERM ? ((R & ~31) + perm32(R & 31)) : R;
        voffA[i] = (unsigned)(R * K + C) * 2u; voffB[i] = (unsigned)(Rb * K + C) * 2u; }
    const size_t kstep = (size_t)(BK * 2);
    const size_t hstep = (size_t)HALF * K * 2;
    const size_t tstep = 2 * hstep;
    const unsigned ldsw = (unsigned)wid * 1024u;
    const int aoff = lds_byte(wr * 64 + fr, fq * 8), boff = lds_byte(wc * 32 + fr, fq * 8);
#define PG8_SA(b, h) (((b) * 2 + (h)) * HTB)
#define PG8_SB(b, h) ((4 + (b) * 2 + (h)) * HTB)
#define PG8_STAGE(bufoff, gbase, voff) do { _Pragma("unroll") for (int _i = 0; _i < 2; ++_i) \
        __builtin_amdgcn_global_load_lds((const unsigned*)((const char*)(gbase) + (voff)[_i]), (PG8_LAS unsigned*)(lds + (bufoff) + ldsw + _i * 8192), 16, 0, 0); } while (0)
#define PG8_LDA(dst, b, h) do { _Pragma("unroll") for (int m = 0; m < 4; ++m) _Pragma("unroll") for (int k = 0; k < 2; ++k) dst[m][k] = *(const PG8_LAS bf16x8*)(lds + PG8_SA(b, h) + aoff + m * 2048 + k * 1024); } while (0)
#define PG8_LDB(dst, b, h) do { _Pragma("unroll") for (int n = 0; n < 2; ++n) _Pragma("unroll") for (int k = 0; k < 2; ++k) dst[n][k] = *(const PG8_LAS bf16x8*)(lds + PG8_SB(b, h) + boff + n * 2048 + k * 1024); } while (0)
#define PG8_MMA(ai, bj, At, Bt) do { __builtin_amdgcn_s_setprio(1); _Pragma("unroll") for (int m = 0; m < 4; ++m) _Pragma("unroll") for (int n = 0; n < 2; ++n) _Pragma("unroll") for (int k = 0; k < 2; ++k) \
        acc[ai][bj][m][n] = __builtin_amdgcn_mfma_f32_16x16x32_bf16(Bt[n][k], At[m][k], acc[ai][bj][m][n], 0, 0, 0); __builtin_amdgcn_s_setprio(0); } while (0)
#define PG8_WAIT_V(n) asm volatile("s_waitcnt vmcnt(" #n ")" ::: "memory")
#define PG8_WAIT_L(n) asm volatile("s_waitcnt lgkmcnt(" #n ")" ::: "memory")
#define PG8_BAR __builtin_amdgcn_s_barrier()
#define PG8_SCHED __builtin_amdgcn_sched_barrier(0)
    Unit cur, nxt; int ui = 0;
    if (!S.next(0, cur)) return;
    f32x4 acc[2][2][4][2];
#pragma unroll
    for (int a = 0; a < 2; ++a)
#pragma unroll
        for (int b = 0; b < 2; ++b)
#pragma unroll
            for (int m = 0; m < 4; ++m)
#pragma unroll
                for (int n = 0; n < 2; ++n) acc[a][b][m][n] = (f32x4){0.f, 0.f, 0.f, 0.f};
    bf16x8 At[4][2], B0[2][2], B1[2][2];
    const char* cA = (const char*)g.A + (size_t)cur.pm * tstep + (size_t)cur.ko * 2; const char* cB = (const char*)g.Bt + (size_t)cur.pn * tstep + (size_t)cur.ko * 2;
    S.a_ready(cur);
    if constexpr (SP2) {
        PG8_STAGE(PG8_SB(0, 0), cB, voffB); PG8_STAGE(PG8_SB(0, 1), cB + hstep, voffB); PG8_STAGE(PG8_SA(0, 0), cA, voffA); PG8_STAGE(PG8_SA(0, 1), cA + hstep, voffA);
        if (wr == 1) PG8_BAR;
        PG8_WAIT_V(2); PG8_BAR;
        PG8_STAGE(PG8_SB(1, 0), cB + kstep, voffB); PG8_STAGE(PG8_SA(1, 0), cA + kstep, voffA); PG8_STAGE(PG8_SB(1, 1), cB + hstep + kstep, voffB);
        PG8_WAIT_V(6); PG8_BAR;
    } else {
        PG8_STAGE(PG8_SB(0, 0), cB, voffB); PG8_STAGE(PG8_SA(0, 0), cA, voffA); PG8_STAGE(PG8_SB(0, 1), cB + hstep, voffB); PG8_STAGE(PG8_SA(0, 1), cA + hstep, voffA);
        if (wr == 1) PG8_BAR;
        PG8_WAIT_V(4); PG8_BAR;
        PG8_STAGE(PG8_SB(1, 0), cB + kstep, voffB); PG8_STAGE(PG8_SA(1, 0), cA + kstep, voffA); PG8_STAGE(PG8_SB(1, 1), cB + hstep + kstep, voffB);
        PG8_WAIT_V(6); PG8_BAR;
    }
    for (;;) {
        const bool has_next = S.next(ui + 1, nxt);
        const char* nA = has_next ? (const char*)g.A + (size_t)nxt.pm * tstep + (size_t)nxt.ko * 2 : cA; const char* nB = has_next ? (const char*)g.Bt + (size_t)nxt.pn * tstep + (size_t)nxt.ko * 2 : cB;
        for (int t = 0; t < nt; t += 2) {
            const bool last = (t == nt - 2);
            const char* a1 = cA + (size_t)(t + 1) * kstep;
            const char* a2 = last ? nA : cA + (size_t)(t + 2) * kstep; const char* b2 = last ? nB : cB + (size_t)(t + 2) * kstep;
            const char* a3 = a2 + kstep; const char* b3 = b2 + kstep;
            if (last && has_next) S.a_ready(nxt);
            if constexpr (SP2) {
            PG8_LDB(B0, 0, 0); PG8_LDB(B1, 0, 1); PG8_SCHED; PG8_LDA(At, 0, 0); PG8_STAGE(PG8_SA(1, 1), a1 + hstep, voffA);
            PG8_WAIT_V(8); PG8_WAIT_L(0); PG8_BAR; PG8_MMA(0, 0, At, B0); PG8_MMA(0, 1, At, B1); PG8_BAR; PG8_SCHED;
            PG8_LDA(At, 0, 1); PG8_STAGE(PG8_SB(0, 0), b2, voffB); PG8_STAGE(PG8_SB(0, 1), b2 + hstep, voffB); PG8_STAGE(PG8_SA(0, 0), a2, voffA);
            PG8_WAIT_V(8); PG8_WAIT_L(0); PG8_BAR; PG8_MMA(1, 0, At, B0); PG8_MMA(1, 1, At, B1); PG8_BAR; PG8_SCHED;
            PG8_LDB(B0, 1, 0); PG8_LDB(B1, 1, 1); PG8_SCHED; PG8_LDA(At, 1, 0); PG8_STAGE(PG8_SA(0, 1), a2 + hstep, voffA);
            PG8_WAIT_V(8); PG8_WAIT_L(0); PG8_BAR; PG8_MMA(0, 0, At, B0); PG8_MMA(0, 1, At, B1); PG8_BAR; PG8_SCHED;
            PG8_LDA(At, 1, 1); PG8_STAGE(PG8_SB(1, 0), b3, voffB); PG8_STAGE(PG8_SB(1, 1), b3 + hstep, voffB); PG8_STAGE(PG8_SA(1, 0), a3, voffA);
            PG8_WAIT_V(8); PG8_WAIT_L(0); PG8_BAR; PG8_MMA(1, 0, At, B0); PG8_MMA(1, 1, At, B1); PG8_BAR; PG8_SCHED;
            } else {
            PG8_LDB(B0, 0, 0); PG8_SCHED; PG8_LDA(At, 0, 0); PG8_STAGE(PG8_SA(1, 1), a1 + hstep, voffA);
            PG8_WAIT_L(8); PG8_BAR; PG8_WAIT_L(0); PG8_MMA(0, 0, At, B0); PG8_BAR; PG8_SCHED;
            PG8_LDB(B1, 0, 1); PG8_STAGE(PG8_SB(0, 0), b2, voffB);
            PG8_BAR; PG8_WAIT_L(0); PG8_MMA(0, 1, At, B1); PG8_BAR;
            PG8_LDA(At, 0, 1); PG8_STAGE(PG8_SA(0, 0), a2, voffA);
            PG8_BAR; PG8_WAIT_L(0); PG8_MMA(1, 0, At, B0); PG8_BAR; PG8_SCHED;
            PG8_STAGE(PG8_SB(0, 1), b2 + hstep, voffB);
            PG8_WAIT_V(6); PG8_BAR; PG8_MMA(1, 1, At, B1); PG8_BAR;
            PG8_LDB(B0, 1, 0); PG8_SCHED; PG8_LDA(At, 1, 0); PG8_STAGE(PG8_SA(0, 1), a2 + hstep, voffA);
            PG8_WAIT_L(8); PG8_BAR; PG8_WAIT_L(0); PG8_MMA(0, 0, At, B0); PG8_BAR; PG8_SCHED;
            PG8_LDB(B1, 1, 1); PG8_STAGE(PG8_SB(1, 0), b3, voffB);
            PG8_BAR; PG8_WAIT_L(0); PG8_MMA(0, 1, At, B1); PG8_BAR;
            PG8_LDA(At, 1, 1); PG8_STAGE(PG8_SA(1, 0), a3, voffA);
            PG8_BAR; PG8_WAIT_L(0); PG8_MMA(1, 0, At, B0); PG8_BAR; PG8_SCHED;
            PG8_STAGE(PG8_SB(1, 1), b3 + hstep, voffB);
            PG8_WAIT_V(6); PG8_BAR; PG8_MMA(1, 1, At, B1); PG8_BAR;
            }
        }
        if constexpr (ALIGN_EPI) { if (wr == 0) PG8_BAR; }
        if constexpr (!Epi::AFTER_DRAIN) { E(acc, cur, wr, wc, fr, fq); S.done(cur); }
        if (!has_next) break;
#pragma unroll
        for (int a = 0; a < 2; ++a)
#pragma unroll
            for (int b = 0; b < 2; ++b)
#pragma unroll
                for (int m = 0; m < 4; ++m)
#pragma unroll
                    for (int n = 0; n < 2; ++n) acc[a][b][m][n] = (f32x4){0.f, 0.f, 0.f, 0.f};
        cur = nxt; cA = nA; cB = nB; ++ui;
        if constexpr (ALIGN_EPI) { if (wr == 1) PG8_BAR; }
    }
    PG8_WAIT_V(0);
    if constexpr (!ALIGN_EPI) { if (wr == 0) PG8_BAR; }
    PG8_BAR;
    if constexpr (Epi::AFTER_DRAIN) { E.fused(acc, cur, wr, wc, fr, fq, lds, wid, lane); S.done(cur); }
#undef PG8_SA
#undef PG8_SB
#undef PG8_STAGE
#undef PG8_LDA
#undef PG8_LDB
#undef PG8_MMA
#undef PG8_WAIT_V
#undef PG8_WAIT_L
#undef PG8_BAR
#undef PG8_SCHED
}
}
#define LAS __attribute__((address_space(3)))
#define GAS __attribute__((address_space(1)))
typedef unsigned short bf16;
typedef short bf16x8 __attribute__((ext_vector_type(8)));
typedef float f32x4 __attribute__((ext_vector_type(4)));
typedef float f32x2 __attribute__((ext_vector_type(2)));
typedef unsigned u32x4 __attribute__((ext_vector_type(4)));
typedef unsigned u32x2 __attribute__((ext_vector_type(2)));
typedef __bf16 bf16x2_t __attribute__((ext_vector_type(2)));

constexpr int NWAVES = 8, NTHR = 512;
constexpr int DM = 2048, NBATCH = 2, SEQ = 16384, CTXL = 256, MLAT = NBATCH * SEQ, MCTX = NBATCH * CTXL, MROWS = MLAT + MCTX;
constexpr int FFH = 5632;
constexpr float EPS = 1e-6f;
constexpr float LOG2E = 1.4426950408889634f;
constexpr size_t MiB = 1u << 20;
enum { I_X = 0, I_C, I_CTX, I_CCTX, I_MODW, I_MODB, I_NORMG, I_FFNWI, I_FFNWO, I_RGWI, I_RGCW, I_RGCB, I_RGGW, I_RGGB, I_RGLAM, I_RGWO,
       I_HGWI, I_HGLB, I_HGGN, I_HGWO, I_MLWI, I_MLQN, I_MLKVN, I_MLUQ, I_MLUKV, I_MLQKG, I_MLWO, I_SWWI, I_SWQKG, I_SWSINK, I_SWWO, N_IN };
constexpr size_t WS_CTL = 0, CTL_ZERO_BYTES = 64 * 1024;
constexpr size_t WS_MODV = 1 * MiB;
constexpr size_t WS_TAB = 2 * MiB;
constexpr size_t WS_XC = 4 * MiB;
constexpr size_t WS_W = 8 * MiB;
constexpr size_t W_RGWI = WS_W, W_RGG = W_RGWI + 16 * MiB, W_RGWO = W_RGG + 2 * MiB, W_HGWI = W_RGWO + 8 * MiB, W_HGWO = W_HGWI + 40 * MiB,
                 W_MLWI = W_HGWO + 8 * MiB, W_MLUQ = W_MLWI + 5 * MiB, W_MLUKV = W_MLUQ + 3 * MiB, W_MLWO = W_MLUKV + 4 * MiB,
                 W_SWWI = W_MLWO + 8 * MiB, W_SWWO = W_SWWI + 12 * MiB, W_FUP = W_SWWO + 8 * MiB, W_FDN = W_FUP + 44 * MiB, W_END = W_FDN + 22 * MiB;
static_assert(W_END == 188 * MiB, "weights map");
constexpr size_t WS_H = 188 * MiB;
constexpr size_t WS_BIG = 318 * MiB;
static_assert(WS_H + (size_t)MROWS * DM * 2 <= WS_BIG, "H");
constexpr size_t B_HID = WS_BIG;
constexpr size_t B_GR = WS_BIG;
constexpr size_t B_CARRY = WS_BIG + 264 * MiB;
constexpr size_t B_HIN = B_CARRY + 20 * MiB;
constexpr size_t SEC = (size_t)MROWS * DM * 2;
constexpr size_t B_HG = WS_BIG;
constexpr size_t B_ST = WS_BIG + 5 * SEC;
constexpr size_t B_DV = B_ST + (size_t)4160 * 65536;
constexpr size_t B_OF = B_DV + 4 * MiB;
constexpr size_t B_OB = B_OF + SEC;
constexpr size_t B_MLC = WS_BIG;
constexpr size_t B_CQN = B_MLC + 82 * MiB;
constexpr size_t B_CKVN = B_CQN + 33 * MiB;
constexpr size_t B_KR = B_CKVN + 33 * MiB;
constexpr size_t B_Q = B_KR + 5 * MiB;
constexpr size_t B_KV = B_Q + 196 * MiB;
constexpr size_t B_KN = B_KV + 261 * MiB;
constexpr size_t B_QKV = WS_BIG;
constexpr size_t B_PART = WS_BIG + 1170 * MiB;
constexpr size_t WS_END = (size_t)1536 * MiB;
static_assert(B_OB + SEC <= WS_END && B_KN + 196 * MiB <= WS_END && B_HID + (size_t)MROWS * FFH * 2 <= WS_END, "workspace map");
constexpr int T_MC_R = 0, T_MS_R = T_MC_R + 256 * 16, T_MC_C = T_MS_R + 256 * 16, T_MS_C = T_MC_C + 64 * 16,
              T_SC_R = T_MS_C + 64 * 16, T_SS_R = T_SC_R + 256 * 32, T_SC_C = T_SS_R + 256 * 32, T_SS_C = T_SC_C + 64 * 32,
              T_LB = T_SS_C + 64 * 32, T_MFIX = T_LB + 2 * 2048, T_SFIX = T_MFIX + 1, T_END = T_MFIX + 4;
constexpr int CW_BAR = 1024;
constexpr int RING_BYTES = 139264, MISC_OFF = RING_BYTES, LDS_BYTES = 147456;

#define LDS_WAIT() asm volatile("s_waitcnt lgkmcnt(0)" ::: "memory")
#define VM_WAIT() asm volatile("s_waitcnt vmcnt(0)" ::: "memory")
__device__ __forceinline__ float bf2f(unsigned short h) { return __uint_as_float((unsigned)h << 16); }
__device__ __forceinline__ float bflo(unsigned w) { return __uint_as_float(w << 16); }
__device__ __forceinline__ float bfhi(unsigned w) { return __uint_as_float(w & 0xffff0000u); }
__device__ __forceinline__ unsigned pk2(float lo, float hi) { f32x2 v = {lo, hi}; bf16x2_t b = __builtin_convertvector(v, bf16x2_t); return __builtin_bit_cast(unsigned, b); }
__device__ __forceinline__ unsigned short f2bf(float f) { return (unsigned short)(pk2(f, 0.f) & 0xffffu); }
__device__ __forceinline__ float fexp(float x) { return __builtin_amdgcn_exp2f(x * LOG2E); }
__device__ __forceinline__ float flog(float x) { return __builtin_amdgcn_logf(x) * 0.6931471805599453f; }
__device__ __forceinline__ float frcp(float x) { return __builtin_amdgcn_rcpf(x); }
__device__ __forceinline__ float sigm(float x) { return frcp(1.f + fexp(-x)); }
__device__ __forceinline__ float silu(float x) { return x * sigm(x); }
__device__ __forceinline__ float frsq(float x) { return __builtin_amdgcn_rsqf(x); }
__device__ __forceinline__ float wave_sum(float v) {
#pragma unroll
    for (int o = 1; o < 64; o <<= 1) v += __shfl_xor(v, o);
    return v;
}
__device__ __forceinline__ float quad_sum(float v) { v += __shfl_xor(v, 1); v += __shfl_xor(v, 2); return v; }
__device__ __forceinline__ void unpack8(const u32x4 w, float (&f)[8]) {
    f[0] = bflo(w.x); f[1] = bfhi(w.x); f[2] = bflo(w.y); f[3] = bfhi(w.y); f[4] = bflo(w.z); f[5] = bfhi(w.z); f[6] = bflo(w.w); f[7] = bfhi(w.w);
}
__device__ __forceinline__ u32x4 pack8(const float (&f)[8]) { u32x4 w; w.x = pk2(f[0], f[1]); w.y = pk2(f[2], f[3]); w.z = pk2(f[4], f[5]); w.w = pk2(f[6], f[7]); return w; }

__device__ __forceinline__ void cvt_item(const float* W, int ldw, bf16* dst, int ldd, LAS float* scr, int lane) {
#pragma unroll 8
    for (int i = 0; i < 32; ++i) { const int kk = 2 * i + (lane >> 5); scr[kk * 33 + (lane & 31)] = W[(size_t)kk * ldw + (lane & 31)]; }
    LDS_WAIT(); asm volatile("" ::: "memory");
    const int c = lane & 7;
#pragma unroll
    for (int j = 0; j < 4; ++j) { const int n = (lane >> 3) + 8 * j; const LAS float* s = scr + (8 * c) * 33 + n;
        u32x4 o; o.x = pk2(s[0 * 33], s[1 * 33]); o.y = pk2(s[2 * 33], s[3 * 33]); o.z = pk2(s[4 * 33], s[5 * 33]); o.w = pk2(s[6 * 33], s[7 * 33]);
        *(GAS u32x4*)(dst + (size_t)n * ldd + 8 * c) = o; }
    LDS_WAIT(); asm volatile("" ::: "memory");
}
template <int MAP> __device__ __forceinline__ void cvt_matrix(const float* W, int K, int N, bf16* D, LAS float* scr, int gw, int NGW, int lane) {
    const int nblk = N / 32, items = (K / 64) * nblk;
    for (int it = gw; it < items; it += NGW) {
        const int kb = it / nblk, nb = it - kb * nblk, n0 = 32 * nb, k0 = 64 * kb;
        int drow = n0;
        if (MAP == 1) { const int up = n0 >= FFH; const int nn = up ? n0 - FFH : n0; drow = 256 * (nn >> 7) + (up ? 128 : 0) + (nn & 127); }
        cvt_item(W + (size_t)k0 * N + n0, N, D + (size_t)drow * K + k0, K, scr, lane);
    }
}
__device__ __forceinline__ void cvt_ffn(const float* wi, const float* wo, int layer, unsigned char* ws, LAS float* scr, int gw, int NGW, int lane) {
    cvt_matrix<1>(wi + (size_t)layer * DM * 2 * FFH, DM, 2 * FFH, (bf16*)(ws + W_FUP), scr, gw, NGW, lane);
    cvt_matrix<0>(wo + (size_t)layer * FFH * DM, FFH, DM, (bf16*)(ws + W_FDN), scr, gw, NGW, lane);
}
__device__ __forceinline__ void sincos_d(float a, float& s, float& c) {
    const double TWO_PI = 6.283185307179586476925286766559, INV_2PI = 0.15915494309189533576888376337251;
    double t = (double)a * INV_2PI; t -= __builtin_rint(t); const double r = t * TWO_PI, r2 = r * r;
    double ts = r, ss = r, tc = 1.0, cc = 1.0;
    for (int n = 1; n <= 15; ++n) { ts *= -r2 / (double)((2 * n) * (2 * n + 1)); ss += ts; tc *= -r2 / (double)((2 * n - 1) * (2 * n)); cc += tc; }
    s = (float)ss; c = (float)cc;
}
__device__ __forceinline__ void prologue(const float* const* in, unsigned char* ws, LAS unsigned char* lds, int bid, int G, int tid) {
    const int lane = tid & 63, wave = tid >> 6, gw = bid * NWAVES + wave, NGW = G * NWAVES, gt = bid * NTHR + tid, NGT = G * NTHR;
    LAS float* scr = (LAS float*)(lds + wave * 16384);
    cvt_matrix<0>(in[I_RGWI], DM, 4096, (bf16*)(ws + W_RGWI), scr, gw, NGW, lane);
    for (int it = gw; it < 512; it += NGW) {
        const int mtx = it >> 3, sub = it & 7, dg = mtx >> 4, k = mtx & 15, kb = sub >> 2, nb = sub & 3;
        const float* W = in[I_RGGW] + (size_t)mtx * 16384; bf16* D = (bf16*)(ws + W_RGG) + ((size_t)k * 512 + dg * 128) * 128;
        cvt_item(W + (size_t)(64 * kb) * 128 + 32 * nb, 128, D + (size_t)(32 * nb) * 128 + 64 * kb, 128, scr, lane);
    }
    cvt_matrix<0>(in[I_RGWO], DM, DM, (bf16*)(ws + W_RGWO), scr, gw, NGW, lane);
    cvt_matrix<0>(in[I_HGWI], DM, 10240, (bf16*)(ws + W_HGWI), scr, gw, NGW, lane);
    cvt_matrix<0>(in[I_HGWO], DM, DM, (bf16*)(ws + W_HGWO), scr, gw, NGW, lane);
    cvt_matrix<0>(in[I_MLWI], DM, 1088, (bf16*)(ws + W_MLWI), scr, gw, NGW, lane);
    for (int i = gt; i < 192 * DM / 8; i += NGT) ((GAS u32x4*)((bf16*)(ws + W_MLWI) + (size_t)1088 * DM))[i] = (u32x4){0u, 0u, 0u, 0u};
    cvt_matrix<0>(in[I_MLUQ], 512, 3072, (bf16*)(ws + W_MLUQ), scr, gw, NGW, lane);
    cvt_matrix<0>(in[I_MLUKV], 512, 4096, (bf16*)(ws + W_MLUKV), scr, gw, NGW, lane);
    cvt_matrix<0>(in[I_MLWO], DM, DM, (bf16*)(ws + W_MLWO), scr, gw, NGW, lane);
    cvt_matrix<0>(in[I_SWWI], DM, 3072, (bf16*)(ws + W_SWWI), scr, gw, NGW, lane);
    cvt_matrix<0>(in[I_SWWO], DM, DM, (bf16*)(ws + W_SWWO), scr, gw, NGW, lane);
    cvt_ffn(in[I_FFNWI], in[I_FFNWO], 0, ws, scr, gw, NGW, lane);
    float* tab = (float*)(ws + WS_TAB);
    for (int i = gt; i < 320 * 16 + 320 * 32; i += NGT) {
        int nf, j, pos, isc; float* cdst; float* sdst;
        if (i < 320 * 16) { nf = 16; const int p = i >> 4; j = i & 15; isc = p >= 256; pos = isc ? p - 256 : p; cdst = tab + (isc ? T_MC_C : T_MC_R) + pos * 16 + j; sdst = tab + (isc ? T_MS_C : T_MS_R) + pos * 16 + j; }
        else { const int i2 = i - 320 * 16; nf = 32; const int p = i2 >> 5; j = i2 & 31; isc = p >= 256; pos = isc ? p - 256 : p; cdst = tab + (isc ? T_SC_C : T_SC_R) + pos * 32 + j; sdst = tab + (isc ? T_SS_C : T_SS_R) + pos * 32 + j; }
        const float inv = exp2f(-((float)j / (float)nf) * 13.287712379549449f);
        const float ang = (float)pos * inv; float s, c; sincos_d(ang, s, c); *cdst = c; *sdst = s;
    }
    for (int i = gt; i < 2 * 2048; i += NGT) {
        const float* lg = in[I_HGLB]; const float a0 = lg[i], a1 = lg[4096 + i], a2 = lg[8192 + i], a3 = lg[12288 + i];
        const float mx = fmaxf(fmaxf(a0, a1), fmaxf(a2, a3)); const float e0 = expf(a0 - mx), e1 = expf(a1 - mx), e2 = expf(a2 - mx), e3 = expf(a3 - mx);
        tab[T_LB + i] = e1 / (e0 + e1 + e2 + e3);
    }
    if (gw == 0) {
        const float* g = in[I_MLQKG];
        const float q0 = g[lane], q1 = g[64 + lane], q2 = g[128 + lane], k0 = g[192 + lane], k1 = g[256 + lane], k2 = g[320 + lane];
        float a0 = fmaxf(q0 * q0, q1 * q1), a1 = q2 * q2, b0 = fmaxf(k0 * k0, k1 * k1), b1 = k2 * k2;
#pragma unroll
        for (int m = 1; m < 64; m <<= 1) { a0 = fmaxf(a0, __shfl_xor(a0, m)); a1 = fmaxf(a1, __shfl_xor(a1, m)); b0 = fmaxf(b0, __shfl_xor(b0, m)); b1 = fmaxf(b1, __shfl_xor(b1, m)); }
        const float bound = sqrtf((128.f * a0 + 64.f * a1) * (128.f * b0 + 64.f * b1)) * 0.07216878364870322f * LOG2E;
        if (lane == 0) tab[T_MFIX] = (bound > 0.f && bound < 60.f) ? bound : 0.f;
        const float* gs = in[I_SWQKG]; const float s0 = gs[lane], s1 = gs[64 + lane], s2 = gs[128 + lane], s3 = gs[192 + lane];
        float c0 = fmaxf(s0 * s0, s1 * s1), c1 = fmaxf(s2 * s2, s3 * s3);
#pragma unroll
        for (int m = 1; m < 64; m <<= 1) { c0 = fmaxf(c0, __shfl_xor(c0, m)); c1 = fmaxf(c1, __shfl_xor(c1, m)); }
        const float bound2 = 128.f * sqrtf(c0 * c1) * 0.08838834764831845f * LOG2E;
        if (lane == 0) tab[T_SFIX] = (bound2 > 0.f && bound2 < 60.f) ? bound2 : 0.f;
    }
    __syncthreads();
    LAS float* cond = (LAS float*)lds; LAS float* part = (LAS float*)(lds + 32768);
    for (int i = tid; i < 3 * DM; i += NTHR) { const float v = i < 2 * DM ? in[I_C][i] : in[I_CCTX][i - 2 * DM]; cond[i] = v / (1.f + expf(-v)); }
    __syncthreads();
    float* modv = (float*)(ws + WS_MODV);
    for (int it = bid; it < 4 * 192; it += G) {
        const int l = it / 192, n0 = (it - l * 192) * 64; const int kq = lane >> 4, c4 = lane & 15;
        f32x4 acc[3] = {{0.f, 0.f, 0.f, 0.f}, {0.f, 0.f, 0.f, 0.f}, {0.f, 0.f, 0.f, 0.f}};
        const float* wp = in[I_MODW] + ((size_t)l * DM + 256 * wave + kq) * 12288 + n0 + 4 * c4;
#pragma unroll 4
        for (int i = 0; i < 64; ++i) { const f32x4 wv = *(const f32x4*)(wp + (size_t)(4 * i) * 12288); const int k = 256 * wave + 4 * i + kq;
            acc[0] += cond[k] * wv; acc[1] += cond[DM + k] * wv; acc[2] += cond[2 * DM + k] * wv; }
#pragma unroll
        for (int ci = 0; ci < 3; ++ci)
#pragma unroll
            for (int e = 0; e < 4; ++e) { float v = acc[ci][e]; v += __shfl_xor(v, 16); v += __shfl_xor(v, 32); acc[ci][e] = v; }
        if (kq == 0) {
#pragma unroll
            for (int ci = 0; ci < 3; ++ci)
#pragma unroll
                for (int e = 0; e < 4; ++e) part[(wave * 3 + ci) * 64 + 4 * c4 + e] = acc[ci][e]; }
        __syncthreads();
        if (tid < 192) { const int ci = tid >> 6, cc = tid & 63; float s = in[I_MODB][l * 12288 + n0 + cc];
#pragma unroll
            for (int w = 0; w < 8; ++w) s += part[(w * 3 + ci) * 64 + cc];
            modv[(size_t)(l * 3 + ci) * 12288 + n0 + cc] = s; }
        __syncthreads();
    }
}

__device__ __forceinline__ void norm_phase(const float* xlat, const float* xctx, const float* g, const float* modv_l, int which, bf16* H, int mrows, int gw, int NGW, int lane,
                                           const float* part, int nsplit, const float* pgate, float* xctx_out) {
    for (int m = mrows - 1 - gw; m >= 0; m -= NGW) {
        const bool isl = m < MLAT; const int ci = isl ? (m >> 14) : 2;
        const float* xr = isl ? xlat + (size_t)m * DM : xctx + (size_t)(m - MLAT) * DM;
        const float* sh = modv_l + ci * 12288 + (which ? 3 : 0) * DM; const float* sc = sh + DM;
        f32x4 v[8]; float s = 0.f;
#pragma unroll
        for (int j = 0; j < 8; ++j) v[j] = ((const f32x4*)xr)[lane + 64 * j];
        if (!isl && part) {
#pragma unroll
            for (int j = 0; j < 8; ++j) { f32x4 a = {0.f, 0.f, 0.f, 0.f};
                for (int q = 0; q < nsplit; ++q) a += ((const f32x4*)(part + ((size_t)q * 512 + (m - MLAT)) * DM))[lane + 64 * j];
                v[j] += ((const f32x4*)pgate)[lane + 64 * j] * a; ((f32x4*)(xctx_out + (size_t)(m - MLAT) * DM))[lane + 64 * j] = v[j]; }
        }
#pragma unroll
        for (int j = 0; j < 8; ++j) s += (v[j].x * v[j].x + v[j].y * v[j].y) + (v[j].z * v[j].z + v[j].w * v[j].w);
        s = wave_sum(s); const float rstd = frsq(s * (1.f / DM) + EPS);
#pragma unroll
        for (int j = 0; j < 8; ++j) { const int c4 = lane + 64 * j; const f32x4 gg = ((const f32x4*)g)[c4], ss = ((const f32x4*)sc)[c4], hh = ((const f32x4*)sh)[c4];
            const f32x4 o = (v[j] * rstd) * gg * (1.f + ss) + hh; u32x2 w; w.x = pk2(o.x, o.y); w.y = pk2(o.z, o.w); ((u32x2*)(H + (size_t)m * DM))[c4] = w; }
    }
}
__device__ __forceinline__ void mla_prep1(const bf16* C, const float* qng, const float* kvng, const float* qkg, const float* tab, bf16* CQN, bf16* CKVN, bf16* KR, int gw, int NGW, int lane) {
    float g1[8], g2[8];
#pragma unroll
    for (int e = 0; e < 8; ++e) { g1[e] = qng[8 * lane + e]; g2[e] = kvng[8 * lane + e]; }
    const float gk = qkg[192 + 128 + lane];
    for (int m0 = gw; m0 < MROWS; m0 += 2 * NGW) {
        const int m1 = m0 + NGW; const bool two = m1 < MROWS;
        u32x4 a[2], b[2]; float kr[2];
#pragma unroll
        for (int r = 0; r < 2; ++r) { const bf16* cr = C + (size_t)(r == 0 || two ? (r == 0 ? m0 : m1) : m0) * 1280;
            a[r] = *(const u32x4*)(cr + 8 * lane); b[r] = *(const u32x4*)(cr + 512 + 8 * lane); kr[r] = bf2f(cr[1024 + lane]); }
#pragma unroll
        for (int r = 0; r < 2; ++r) { if (r == 1 && !two) break; const int m = r == 0 ? m0 : m1;
            float fa[8], fb[8]; unpack8(a[r], fa); unpack8(b[r], fb); float sa = 0.f, sb = 0.f;
#pragma unroll
            for (int e = 0; e < 8; ++e) { sa += fa[e] * fa[e]; sb += fb[e] * fb[e]; }
            sa = wave_sum(sa); sb = wave_sum(sb); const float sk = wave_sum(kr[r] * kr[r]);
            const float ra = frsq(sa * (1.f / 512.f) + EPS), rb = frsq(sb * (1.f / 512.f) + EPS), rk = frsq(sk * (1.f / 64.f) + EPS);
#pragma unroll
            for (int e = 0; e < 8; ++e) { fa[e] = fa[e] * ra * g1[e]; fb[e] = fb[e] * rb * g2[e]; }
            *(u32x4*)(CQN + (size_t)m * 512 + 8 * lane) = pack8(fa); *(u32x4*)(CKVN + (size_t)m * 512 + 8 * lane) = pack8(fb);
            float y = kr[r] * rk * gk; const float py = __shfl_xor(y, 16);
            if (m < MLAT) { const int t = m & (SEQ - 1), j = lane & 15; const bool isr = lane < 32; const int pos = isr ? (t >> 6) : (t & 63);
                const float cs = tab[(isr ? T_MC_R : T_MC_C) + pos * 16 + j], sn = tab[(isr ? T_MS_R : T_MS_C) + pos * 16 + j];
                y = ((lane >> 4) & 1) ? py * sn + y * cs : y * cs - py * sn; }
            KR[(size_t)m * 64 + lane] = f2bf(y); }
    }
}
__device__ __forceinline__ void mla_prep2(bf16* Q, const bf16* KV, const bf16* KR, bf16* KN, const float* qkg, const float* tab, int gw, int NGW, int lane, const float qscale) {
    const int h = lane >> 2, s = lane & 3;
    float gkn[32];
#pragma unroll
    for (int i = 0; i < 32; ++i) gkn[i] = qkg[192 + 32 * s + i];
    for (int m = gw; m < MROWS; m += NGW) {
        float x[32];
        const bf16* kp = KV + (size_t)m * 4096 + h * 256 + 32 * s; bf16* kn = KN + (size_t)m * 3072 + h * 192; float sk = 0.f;
#pragma unroll
        for (int v = 0; v < 4; ++v) { float f[8]; unpack8(*(const u32x4*)(kp + 8 * v), f);
#pragma unroll
            for (int e = 0; e < 8; ++e) { x[8 * v + e] = f[e]; sk += f[e] * f[e]; } }
        sk = quad_sum(sk); const float rk = frsq(sk * (1.f / 128.f) + EPS);
#pragma unroll
        for (int v = 0; v < 4; ++v) { float f[8];
#pragma unroll
            for (int e = 0; e < 8; ++e) f[e] = x[8 * v + e] * rk * gkn[8 * v + e];
            *(u32x4*)(kn + 32 * s + 8 * v) = pack8(f); }
        const u32x4 k0 = *(const u32x4*)(KR + (size_t)m * 64 + 16 * s), k1 = *(const u32x4*)(KR + (size_t)m * 64 + 16 * s + 8);
        *(u32x4*)(kn + 128 + 16 * s) = k0; *(u32x4*)(kn + 128 + 16 * s + 8) = k1;
    }
}
__device__ __forceinline__ void swa_norm_rope(bf16* p, const float (&g)[32], bool isl, int t, int s, const float* tab, bool store) {
    float x[32]; float ss = 0.f;
#pragma unroll
    for (int v = 0; v < 4; ++v) { float f[8]; unpack8(*(const u32x4*)(p + 8 * v), f);
#pragma unroll
        for (int e = 0; e < 8; ++e) { x[8 * v + e] = f[e]; ss += f[e] * f[e]; } }
    const int pos = (s < 2) ? (t >> 6) : (t & 63); const float* tc = tab + ((s < 2) ? T_SC_R : T_SC_C) + pos * 32; const float* ts = tab + ((s < 2) ? T_SS_R : T_SS_C) + pos * 32;
    f32x4 cv[8], sv[8];
#pragma unroll
    for (int v = 0; v < 8; ++v) { cv[v] = ((const f32x4*)tc)[v]; sv[v] = ((const f32x4*)ts)[v]; }
    ss = quad_sum(ss); const float rn = frsq(ss * (1.f / 128.f) + EPS);
#pragma unroll
    for (int v = 0; v < 4; ++v) { float f[8];
#pragma unroll
        for (int e = 0; e < 8; ++e) { const int j = 8 * v + e; float y = x[j] * rn * g[j]; const float py = __shfl_xor(y, 1);
            const float cs = isl ? cv[j >> 2][j & 3] : 1.f, sn = isl ? sv[j >> 2][j & 3] : 0.f;
            y = (s & 1) ? py * sn + y * cs : y * cs - py * sn;
            f[e] = y; }
        if (store) *(u32x4*)(p + 8 * v) = pack8(f); }
}
__device__ __forceinline__ void swa_prep(bf16* QKV, const float* qkg, const float* tab, int gw, int NGW, int lane) {
    const int h = (lane >> 2) & 3, s = lane & 3;
    float gk[32];
#pragma unroll
    for (int i = 0; i < 32; ++i) gk[i] = qkg[128 + 32 * s + i];
    for (int m = 4 * gw + (lane >> 4); m < MROWS; m += 4 * NGW) {
        const bool isl = m < MLAT; const int t = m & (SEQ - 1);
        swa_norm_rope(QKV + (size_t)m * 3072 + 2048 + h * 128 + 32 * s, gk, isl, t, s, tab, true);
    }
}
__device__ __forceinline__ void gla_final(const bf16* OF, const bf16* OB, const bf16* Gs, const float* gn, bf16* Y, int gw, int NGW, int lane) {
    const int h = lane >> 2, s = lane & 3;
    float gng[32];
#pragma unroll
    for (int i = 0; i < 32; ++i) gng[i] = gn[32 * s + i];
    for (int m = gw; m < MROWS; m += NGW) {
        const size_t off = (size_t)m * DM + h * 128 + 32 * s; float x[32]; float ss = 0.f;
#pragma unroll
        for (int v = 0; v < 4; ++v) { float a[8], b[8]; unpack8(*(const u32x4*)(OF + off + 8 * v), a); unpack8(*(const u32x4*)(OB + off + 8 * v), b);
#pragma unroll
            for (int e = 0; e < 8; ++e) { const float o = a[e] + b[e]; x[8 * v + e] = o; ss += o * o; } }
        ss = quad_sum(ss); const float rn = frsq(ss * (1.f / 128.f) + EPS);
#pragma unroll
        for (int v = 0; v < 4; ++v) { float gg[8], f[8]; unpack8(*(const u32x4*)(Gs + off + 8 * v), gg);
#pragma unroll
            for (int e = 0; e < 8; ++e) f[e] = x[8 * v + e] * rn * gng[8 * v + e] * silu(gg[e]);
            *(u32x4*)(Y + off + 8 * v) = pack8(f); }
    }
}
#define XB_TMO      128
#define XB_XCNT(j)  (256  + 64 * (j))
#define XB_XSUB(j)  (1280 + 64 * (j))
#define XB_XGEN(j)  (2304 + 64 * (j))
#define XB_TOP      3328
#define XB_TOPGEN   3392
#define XCD_BAR_WORDS 3456
#define XB_SPIN_CAP (1u << 18)

__device__ __forceinline__ unsigned xb_ld(unsigned* p)              { return __hip_atomic_load(p, __ATOMIC_RELAXED, __HIP_MEMORY_SCOPE_AGENT); }
__device__ __forceinline__ unsigned xb_add(unsigned* p, unsigned v) { return __hip_atomic_fetch_add(p, v, __ATOMIC_RELAXED, __HIP_MEMORY_SCOPE_AGENT); }
__device__ __forceinline__ unsigned xb_xcc_id() { return (unsigned)__builtin_amdgcn_s_getreg((3 << 11) | 20) & 0xFu; }
#define XB_SPIN(cond, bar) do { unsigned _sp = 0; while (cond) { __builtin_amdgcn_s_sleep(1); \
    if ((++_sp & 255u) == 0u) { if (xb_ld(&(bar)[XB_TMO])) break; if (_sp > XB_SPIN_CAP) { atomicAdd(&(bar)[XB_TMO], 1u); break; } } } } while (0)

struct XcdBarrier {
    unsigned* bar; unsigned x;
    volatile LAS unsigned* st;
};

__device__ __forceinline__ XcdBarrier xcd_barrier_post(unsigned* bar, volatile LAS unsigned* st) {
    XcdBarrier b; b.bar = bar; b.x = xb_xcc_id(); b.st = st;
    if (threadIdx.x == 0) (void)xb_add(&bar[XB_XCNT(b.x)], 1u);
    return b;
}
__device__ __forceinline__ void xcd_barrier_complete(unsigned* bar, unsigned x, unsigned& nloc, unsigned& nx) {
    const unsigned G = gridDim.x * gridDim.y * gridDim.z;
    unsigned sum, cnt, mine, sp = 0u;
    for (;;) {
        sum = 0u; cnt = 0u; mine = 0u;
#pragma unroll
        for (unsigned j = 0; j < 16; ++j) { const unsigned c = xb_ld(&bar[XB_XCNT(j)]); sum += c; cnt += (c > 0u) ? 1u : 0u; mine = (j == x) ? c : mine; }
        if (sum == G) break;
        __builtin_amdgcn_s_sleep(1);
        if ((++sp & 255u) == 0u) { if (xb_ld(&bar[XB_TMO])) break; if (sp > XB_SPIN_CAP) { atomicAdd(&bar[XB_TMO], 1u); break; } }
    }
    nloc = mine > 0u ? mine : 1u; nx = cnt > 0u ? cnt : 1u;
}

__device__ __forceinline__ void xcd_barrier(const XcdBarrier& b) {
    asm volatile("s_waitcnt vmcnt(0)" ::: "memory");
    __syncthreads();
    if (threadIdx.x == 0) {
        unsigned* bar = b.bar;
        __builtin_amdgcn_s_waitcnt(0);
        unsigned nloc = b.st[0], nx = b.st[1];
        if (nloc == 0u) { xcd_barrier_complete(bar, b.x, nloc, nx); b.st[0] = nloc; b.st[1] = nx; }
        const unsigned old = xb_add(&bar[XB_XSUB(b.x)], 1u);
        const unsigned gen = old / nloc;
        if (old + 1u == (gen + 1u) * nloc) {
            __builtin_amdgcn_fence(__ATOMIC_RELEASE, "agent");
            asm volatile("s_waitcnt vmcnt(0)" ::: "memory");
            const unsigned og = xb_add(&bar[XB_TOP], 1u);
            const unsigned tg = og / nx;
            if (og + 1u == (tg + 1u) * nx) xb_add(&bar[XB_TOPGEN], 1u);
            else XB_SPIN(xb_ld(&bar[XB_TOPGEN]) == tg, bar);
            __builtin_amdgcn_fence(__ATOMIC_ACQUIRE, "agent");
            xb_add(&bar[XB_XGEN(b.x)], 1u);
            asm volatile("s_waitcnt vmcnt(0)" ::: "memory");
        } else {
            XB_SPIN(xb_ld(&bar[XB_XGEN(b.x)]) == gen, bar);
            __builtin_amdgcn_fence(__ATOMIC_ACQUIRE, "agent");
            asm volatile("s_waitcnt vmcnt(0)" ::: "memory");
        }
    }
    __syncthreads();
}
__device__ __forceinline__ f32x4 mm16(const LAS unsigned char* A, int lda, const LAS unsigned char* Bt, int ldb, int ksteps, f32x4 acc, int l15, int quad) {
    const LAS unsigned char* ap = A + l15 * lda + quad * 16; const LAS unsigned char* bp = Bt + l15 * ldb + quad * 16;
    for (int kk = 0; kk < ksteps; ++kk) {
        const bf16x8 a = *(const LAS bf16x8*)(ap + kk * 64), b = *(const LAS bf16x8*)(bp + kk * 64);
        acc = __builtin_amdgcn_mfma_f32_16x16x32_bf16(a, b, acc, 0, 0, 0);
    }
    return acc;
}

#define LDS_BARRIER() do { asm volatile("s_waitcnt lgkmcnt(0)" ::: "memory"); __builtin_amdgcn_s_barrier(); asm volatile("" ::: "memory"); } while (0)
struct AB { float a, b; };
__device__ __forceinline__ AB comb(AB e1, AB e2) { AB r; r.a = e1.a * e2.a; r.b = e2.a * e1.b + e2.b; return r; }
__device__ __forceinline__ AB shfl_ab_up(AB v, int d) { AB r; r.a = __shfl_up(v.a, d); r.b = __shfl_up(v.b, d); return r; }
__device__ __forceinline__ AB shfl_ab_dn(AB v, int d) { AB r; r.a = __shfl_down(v.a, d); r.b = __shfl_down(v.b, d); return r; }
__device__ __forceinline__ AB shfl_ab(AB v, int l) { AB r; r.a = __shfl(v.a, l); r.b = __shfl(v.b, l); return r; }
constexpr int RG_U32 = 0, RG_UBF = 33792, RG_OSUM = RG_UBF + 17408, RG_CW = RG_OSUM + 33792, RG_END = RG_CW + 2560;
template <int PASS> __device__ __forceinline__ void rglru_items(const bf16* GR, const float* convw, const float* convb, const bf16* WG, const float* gateb, const float* lam,
                                                                float* CARRY, const float* HIN, bf16* Y, LAS unsigned char* lds, int bid, int G, int tid) {
    const int lane = tid & 63, w = tid >> 6, l15 = lane & 15, quad = lane >> 4;
    LAS float* U32 = (LAS float*)(lds + RG_U32); LAS unsigned char* UBF = lds + RG_UBF; LAS float* OSUM = (LAS float*)(lds + RG_OSUM);
    int kcur = -1; float sp[2], gb[2][2]; bf16x8 bfr[2][2][4]; LAS float* CW = (LAS float*)(lds + RG_CW);
    u32x4 pre[4][2]; bool pre_ok[4];
    const int tt = tid >> 3, cg = tid & 7;
#define RG_SEQ(r0_, s0_, s1_) do { if ((r0_) < MLAT) { s0_ = (r0_) & ~(SEQ - 1); s1_ = s0_ + SEQ; } else { s0_ = MLAT + (((r0_) - MLAT) & ~(CTXL - 1)); s1_ = s0_ + CTXL; } } while (0)
#define RG_PREFETCH(item_) do { const int k_ = (item_) & 15, r0_ = ((item_) >> 4) * 64; int s0_, s1_; RG_SEQ(r0_, s0_, s1_); const int c0_ = k_ * 128 + cg * 16; \
        _Pragma("unroll") for (int j = 0; j < 4; ++j) { const int rr = r0_ + tt + j - 2; pre_ok[j] = rr >= s0_ && rr < s1_; \
            if (pre_ok[j]) { pre[j][0] = *(const u32x4*)(GR + (size_t)rr * 4096 + 2048 + c0_); pre[j][1] = *(const u32x4*)(GR + (size_t)rr * 4096 + 2048 + c0_ + 8); } } } while (0)
    if (bid < 520 * 16) RG_PREFETCH(bid);
    for (int item = bid; item < 520 * 16; item += G) {
        const int k = item & 15, ch = item >> 4, r0 = ch * 64;
        const int c = k * 128 + 16 * w + l15;
        if (k != kcur) { kcur = k;
#pragma unroll
            for (int d = 0; d < 2; ++d)
#pragma unroll
                for (int g = 0; g < 2; ++g)
#pragma unroll
                    for (int kk = 0; kk < 4; ++kk) bfr[d][g][kk] = *(const bf16x8*)(WG + ((size_t)k * 512 + (d * 2 + g) * 128 + 16 * w + l15) * 128 + kk * 32 + quad * 8);
            LDS_BARRIER();
            for (int i = tid; i < 5 * 128; i += NTHR) { const int j = i >> 7, cc_ = i & 127; CW[i] = j < 4 ? convw[j * 2048 + k * 128 + cc_] : convb[k * 128 + cc_]; }
            LDS_BARRIER();
        }
        {
            float acc[16];
#pragma unroll
            for (int v = 0; v < 4; ++v) { const f32x4 b4 = *(const LAS f32x4*)(CW + 4 * 128 + cg * 16 + 4 * v); acc[4 * v] = b4.x; acc[4 * v + 1] = b4.y; acc[4 * v + 2] = b4.z; acc[4 * v + 3] = b4.w; }
#pragma unroll
            for (int j = 0; j < 4; ++j) { if (pre_ok[j]) { float x0[8], x1[8]; unpack8(pre[j][0], x0); unpack8(pre[j][1], x1);
#pragma unroll
                    for (int v = 0; v < 2; ++v) { const f32x4 wa = *(const LAS f32x4*)(CW + j * 128 + cg * 16 + 4 * v), wb = *(const LAS f32x4*)(CW + j * 128 + cg * 16 + 8 + 4 * v);
                        acc[4 * v] += wa.x * x0[4 * v]; acc[4 * v + 1] += wa.y * x0[4 * v + 1]; acc[4 * v + 2] += wa.z * x0[4 * v + 2]; acc[4 * v + 3] += wa.w * x0[4 * v + 3];
                        acc[8 + 4 * v] += wb.x * x1[4 * v]; acc[8 + 4 * v + 1] += wb.y * x1[4 * v + 1]; acc[8 + 4 * v + 2] += wb.z * x1[4 * v + 2]; acc[8 + 4 * v + 3] += wb.w * x1[4 * v + 3]; } } }
#pragma unroll
            for (int v = 0; v < 4; ++v) *(LAS f32x4*)(U32 + tt * 132 + cg * 16 + 4 * v) = (f32x4){acc[4 * v], acc[4 * v + 1], acc[4 * v + 2], acc[4 * v + 3]};
            float f0[8], f1[8];
#pragma unroll
            for (int e = 0; e < 8; ++e) { f0[e] = acc[e]; f1[e] = acc[8 + e]; }
            *(LAS u32x4*)(UBF + tt * 272 + cg * 32) = pack8(f0); *(LAS u32x4*)(UBF + tt * 272 + cg * 32 + 16) = pack8(f1);
        }
        if (item + G < 520 * 16) RG_PREFETCH(item + G);
        LDS_BARRIER();
#pragma unroll
        for (int d = 0; d < 2; ++d) { const float y = fexp(-lam[d * 2048 + c]); sp[d] = (y < 0.03f) ? y * (1.f - y * (0.5f - y * (0.33333334f - 0.25f * y))) : flog(1.f + y);
            gb[d][0] = gateb[(d * 2 + 0) * 2048 + c]; gb[d][1] = gateb[(d * 2 + 1) * 2048 + c]; }
        float Aa[2][4][4], Bx[2][4][4];
#pragma unroll
        for (int rb = 0; rb < 4; ++rb) {
            f32x4 ac[2][2] = {{{0.f, 0.f, 0.f, 0.f}, {0.f, 0.f, 0.f, 0.f}}, {{0.f, 0.f, 0.f, 0.f}, {0.f, 0.f, 0.f, 0.f}}};
#pragma unroll
            for (int kk = 0; kk < 4; ++kk) { const bf16x8 a = *(const LAS bf16x8*)(UBF + (rb * 16 + l15) * 272 + kk * 64 + quad * 16);
#pragma unroll
                for (int d = 0; d < 2; ++d)
#pragma unroll
                    for (int g = 0; g < 2; ++g) ac[d][g] = __builtin_amdgcn_mfma_f32_16x16x32_bf16(a, bfr[d][g][kk], ac[d][g], 0, 0, 0); }
#pragma unroll
            for (int i = 0; i < 4; ++i) { const float uv = U32[(rb * 16 + quad * 4 + i) * 132 + 16 * w + l15];
#pragma unroll
                for (int d = 0; d < 2; ++d) { const float rg = sigm(ac[d][0][i] + gb[d][0]), ig = sigm(ac[d][1][i] + gb[d][1]);
                    const float la = -8.f * rg * sp[d], z = 2.f * la, av = fexp(la); const float om = (z > -0.01f) ? -z * (1.f + z * (0.5f + z * 0.16666667f)) : 1.f - av * av;
                    Aa[d][rb][i] = av; Bx[d][rb][i] = __builtin_amdgcn_sqrtf(om) * ig * uv; } }
        }
        u32x4 gq0, gq1;
        if (PASS == 2) { gq0 = *(const u32x4*)(GR + (size_t)(r0 + tt) * 4096 + k * 128 + cg * 16); gq1 = *(const u32x4*)(GR + (size_t)(r0 + tt) * 4096 + k * 128 + cg * 16 + 8); }
        float hs[4][4];
#pragma unroll
        for (int rb = 0; rb < 4; ++rb)
#pragma unroll
            for (int i = 0; i < 4; ++i) hs[rb][i] = 0.f;
#pragma unroll
        for (int d = 0; d < 2; ++d) {
            AB tot; tot.a = 1.f; tot.b = 0.f; float Hc = 0.f;
            if (PASS == 2) Hc = HIN[((size_t)ch * 2 + d) * 2048 + c];
#pragma unroll
            for (int rbi = 0; rbi < 4; ++rbi) { const int rb = d == 0 ? rbi : 3 - rbi;
                AB seg; seg.a = 1.f; seg.b = 0.f;
#pragma unroll
                for (int ii = 0; ii < 4; ++ii) { const int i = d == 0 ? ii : 3 - ii; seg.b = Aa[d][rb][i] * seg.b + Bx[d][rb][i]; seg.a = seg.a * Aa[d][rb][i]; }
                AB inc = seg, t, rbt, ex;
                if (d == 0) { t = shfl_ab_up(inc, 16); if (quad >= 1) inc = comb(t, inc); t = shfl_ab_up(inc, 32); if (quad >= 2) inc = comb(t, inc); rbt = shfl_ab(inc, 48 + l15);
                              ex = shfl_ab_up(inc, 16); if (quad == 0) { ex.a = 1.f; ex.b = 0.f; } }
                else        { t = shfl_ab_dn(inc, 16); if (quad <= 2) inc = comb(t, inc); t = shfl_ab_dn(inc, 32); if (quad <= 1) inc = comb(t, inc); rbt = shfl_ab(inc, l15);
                              ex = shfl_ab_dn(inc, 16); if (quad == 3) { ex.a = 1.f; ex.b = 0.f; } }
                if (PASS == 1) tot = comb(tot, rbt);
                else { float s = ex.a * Hc + ex.b;
#pragma unroll
                    for (int ii = 0; ii < 4; ++ii) { const int i = d == 0 ? ii : 3 - ii; s = Aa[d][rb][i] * s + Bx[d][rb][i]; hs[rb][i] += s; }
                    Hc = rbt.a * Hc + rbt.b; }
            }
            if (PASS == 1 && quad == 0) { CARRY[(((size_t)ch * 2 + d) * 2 + 0) * 2048 + c] = tot.a; CARRY[(((size_t)ch * 2 + d) * 2 + 1) * 2048 + c] = tot.b; }
        }
        if (PASS == 2) {
#pragma unroll
            for (int rb = 0; rb < 4; ++rb)
#pragma unroll
                for (int i = 0; i < 4; ++i) OSUM[(rb * 16 + quad * 4 + i) * 132 + 16 * w + l15] = hs[rb][i];
            LDS_BARRIER();
            const int r = r0 + tt, c0 = k * 128 + cg * 16;
            float g0[8], g1[8], o0[8], o1[8]; unpack8(gq0, g0); unpack8(gq1, g1);
#pragma unroll
            for (int e = 0; e < 8; ++e) { const float x = g0[e], x2 = g1[e];
                o0[e] = x * sigm(1.5957691216f * (x + 0.044715f * x * x * x)) * OSUM[tt * 132 + cg * 16 + e];
                o1[e] = x2 * sigm(1.5957691216f * (x2 + 0.044715f * x2 * x2 * x2)) * OSUM[tt * 132 + cg * 16 + 8 + e]; }
            *(u32x4*)(Y + (size_t)r * DM + c0) = pack8(o0); *(u32x4*)(Y + (size_t)r * DM + c0 + 8) = pack8(o1);
        }
        LDS_BARRIER();
    }
}
__device__ __forceinline__ void rglru_prop(const float* __restrict__ CARRY, float* __restrict__ HIN, LAS float* sm, int bid, int G, int tid) {
    const int cl = tid & 31, seg = tid >> 5;
    for (int grp = bid; grp < 256; grp += G) {
        const int c = (grp & 63) * 32 + cl, d = (grp >> 6) & 1, b = grp >> 7;
        float a[20], bb[20]; int chs[20]; float A = 1.f, B = 0.f;
        if (seg < 13) {
#pragma unroll
            for (int k = 0; k < 20; ++k) { const int step = seg * 20 + k;
                int ch; if (d == 0) ch = step < 4 ? (512 + 4 * b + step) : (256 * b + step - 4); else ch = step < 4 ? (512 + 4 * b + 3 - step) : (256 * b + 255 - (step - 4));
                chs[k] = ch; a[k] = CARRY[(((size_t)ch * 2 + d) * 2 + 0) * 2048 + c]; bb[k] = CARRY[(((size_t)ch * 2 + d) * 2 + 1) * 2048 + c]; }
#pragma unroll
            for (int k = 0; k < 20; ++k) { B = a[k] * B + bb[k]; A = a[k] * A; }
            sm[(seg * 32 + cl) * 2] = A; sm[(seg * 32 + cl) * 2 + 1] = B;
        }
        __syncthreads();
        if (seg < 13) { float H = 0.f;
            for (int q = 0; q < seg; ++q) H = sm[(q * 32 + cl) * 2] * H + sm[(q * 32 + cl) * 2 + 1];
#pragma unroll
            for (int k = 0; k < 20; ++k) { HIN[((size_t)chs[k] * 2 + d) * 2048 + c] = H; H = a[k] * H + bb[k]; } }
        __syncthreads();
    }
}

constexpr int GL_QT = 0, GL_KT = 17408, GL_QS = 34816, GL_KST = 52224, GL_VT = 70656, GL_ST = 89088, GL_PP = 123904, GL_SEGT = 133120, GL_DVEC = 135168, GL_END = 135680;
static_assert(GL_END <= RING_BYTES && RG_END <= RING_BYTES, "LDS");
template <int PASS> __device__ __forceinline__ void gla_items(const bf16* HG, const float* lbv, float* ST, float* DVG, bf16* OFb, bf16* OBb, LAS unsigned char* lds, int bid, int G, int tid) {
    const int lane = tid & 63, w = tid >> 6, l15 = lane & 15, quad = lane >> 4;
    const int dk = tid & 127, seg = tid >> 7;
    LAS float* SEGT = (LAS float*)(lds + GL_SEGT); LAS float* DVEC = (LAS float*)(lds + GL_DVEC);
    const size_t SECE = (size_t)MROWS * DM;
    u32x4 rz[2], rv[2], rq[2];
#define GL_DECODE(item_, sc_, h_, d_, b_, R0_) const int sc_ = (item_) % 65, h_ = ((item_) / 65) & 15, d_ = ((item_) / 1040) & 1, b_ = (item_) / 2080; \
        const int R0_ = sc_ == 0 ? MLAT + CTXL * b_ : SEQ * b_ + 256 * (d_ == 0 ? sc_ - 1 : 64 - sc_)
#define GL_FETCH(item_, cc_) do { GL_DECODE(item_, fsc_, fh_, fd_, fb_, fR0_); (void)fsc_; (void)fb_; \
        _Pragma("unroll") for (int hf = 0; hf < 2; ++hf) { const int p = (tid >> 4) + 32 * hf; const int tok = fd_ == 0 ? fR0_ + 64 * (cc_) + p : fR0_ + 255 - 64 * (cc_) - p; \
            const bf16* rowp = HG + (size_t)tok * DM + fh_ * 128 + (tid & 15) * 8; \
            rz[hf] = *(const u32x4*)(rowp + (size_t)(1 + fd_) * SECE); rv[hf] = *(const u32x4*)(rowp + 3 * SECE); if (PASS == 2) rq[hf] = *(const u32x4*)rowp; } } while (0)
    unsigned tch = 0u;
#define GL_TOUCH(item_, cc_) do { if (tid < (PASS == 2 ? 384 : 256)) { GL_DECODE(item_, tsc_, th_, td_, tb_, tR0_); (void)tsc_; (void)tb_; const int p = tid & 63, hl = (tid >> 6) & 1, sec = tid >> 7; \
            const int tok = td_ == 0 ? tR0_ + 64 * (cc_) + p : tR0_ + 255 - 64 * (cc_) - p; \
            tch = *(const unsigned*)(HG + (size_t)tok * DM + th_ * 128 + hl * 64 + (size_t)(sec == 0 ? 1 + td_ : sec == 1 ? 3 : 0) * SECE); } } while (0)
    if (bid < 4160) { GL_FETCH(bid, 0); GL_TOUCH(bid, 1); }
    for (int item = bid; item < 4160; item += G) {
        GL_DECODE(item, sc, h, d, b, R0); (void)sc; (void)b;
        const float lb = lbv[d * 2048 + h * 128 + dk], oml = 1.f - lb;
        bf16* OD = d == 0 ? OFb : OBb;
        f32x4 sacc[8];
#pragma unroll
        for (int j = 0; j < 8; ++j) sacc[j] = (f32x4){0.f, 0.f, 0.f, 0.f};
        if (PASS == 2) {
            const float* sp = ST + (size_t)item * 16384;
#pragma unroll
            for (int j = 0; j < 8; ++j)
#pragma unroll
                for (int i = 0; i < 4; ++i) { const float v = sp[(16 * w + quad * 4 + i) * 128 + 16 * j + l15]; sacc[j][i] = v;
                    *(LAS unsigned short*)(lds + GL_ST + (16 * w + quad * 4 + i) * 272 + (16 * j + l15) * 2) = f2bf(v); }
        }
        float ctotal = 0.f;
        for (int cc = 0; cc < 4; ++cc) {
#pragma unroll
            for (int hf = 0; hf < 2; ++hf) { const int p = (tid >> 4) + 32 * hf, c16 = tid & 15;
                *(LAS u32x4*)(lds + GL_KT + p * 272 + c16 * 16) = rz[hf]; *(LAS u32x4*)(lds + GL_QS + p * 272 + c16 * 16) = rv[hf];
                if (PASS == 2) *(LAS u32x4*)(lds + GL_QT + p * 272 + c16 * 16) = rq[hf]; }
            LDS_BARRIER();
            asm volatile("" :: "v"(tch));
            if (cc < 3) GL_FETCH(item, cc + 1); else if (item + G < 4160) GL_FETCH(item + G, 0);
            if (cc < 2) GL_TOUCH(item, cc + 2); else if (item + G < 4160) GL_TOUCH(item + G, cc - 2);
            float lc[16], kv[16], vv[16], qq[16]; float run = 0.f;
#pragma unroll
            for (int i = 0; i < 16; ++i) { const int p = 16 * seg + i;
                const float z = bf2f(*(const LAS unsigned short*)(lds + GL_KT + p * 272 + dk * 2)); vv[i] = bf2f(*(const LAS unsigned short*)(lds + GL_QS + p * 272 + dk * 2));
                if (PASS == 2) qq[i] = silu(bf2f(*(const LAS unsigned short*)(lds + GL_QT + p * 272 + dk * 2)));
                const float e = fexp(-z), inv = frcp(1.f + e); kv[i] = oml * e * inv; const float f = lb + oml * inv; run += flog(f); lc[i] = run; }
            SEGT[seg * 128 + dk] = run;
            LDS_BARRIER();
            const float t0 = SEGT[dk], t1 = SEGT[128 + dk], t2 = SEGT[256 + dk], t3 = SEGT[384 + dk];
            const float off = seg == 0 ? 0.f : seg == 1 ? t0 : seg == 2 ? t0 + t1 : t0 + t1 + t2; const float cref = t0 + t1, clast = (t0 + t1) + (t2 + t3);
            ctotal += clast;
            float ks[16];
            const float ecr = fexp(cref), ecl = fexp(clast - cref);
#pragma unroll
            for (int i = 0; i < 16; ++i) { const int p = 16 * seg + i; const float cum = off + lc[i];
                if (PASS == 2) { const float e1 = fexp(cum - cref), e2 = fexp(cref - cum), qe = qq[i] * e1, ke = kv[i] * e2; ks[i] = ke * ecl;
                    *(LAS unsigned short*)(lds + GL_QT + p * 272 + dk * 2) = f2bf(qe);
                    *(LAS unsigned short*)(lds + GL_KT + p * 272 + dk * 2) = f2bf(ke);
                    *(LAS unsigned short*)(lds + GL_QS + p * 272 + dk * 2) = f2bf(qe * ecr); }
                else ks[i] = kv[i] * fexp(clast - cum); }
            { float f0[8], f1[8];
#pragma unroll
              for (int e = 0; e < 8; ++e) { f0[e] = ks[e]; f1[e] = ks[8 + e]; }
              *(LAS u32x4*)(lds + GL_KST + dk * 144 + seg * 32) = pack8(f0); *(LAS u32x4*)(lds + GL_KST + dk * 144 + seg * 32 + 16) = pack8(f1);
#pragma unroll
              for (int e = 0; e < 8; ++e) { f0[e] = vv[e]; f1[e] = vv[8 + e]; }
              *(LAS u32x4*)(lds + GL_VT + dk * 144 + seg * 32) = pack8(f0); *(LAS u32x4*)(lds + GL_VT + dk * 144 + seg * 32 + 16) = pack8(f1); }
            if (seg == 0) DVEC[dk] = fexp(clast);
            LDS_BARRIER();
            if (PASS == 2) {
                const int pb = w >> 1;
#pragma unroll
                for (int sbl = 0; sbl < 2; ++sbl) { const int sb = 2 * (w & 1) + sbl; f32x4 a4 = {0.f, 0.f, 0.f, 0.f};
                    if (sb <= pb) a4 = mm16(lds + GL_QT + pb * 16 * 272, 272, lds + GL_KT + sb * 16 * 272, 272, 4, a4, l15, quad);
#pragma unroll
                    for (int i = 0; i < 4; ++i) { const int p = pb * 16 + quad * 4 + i, s = sb * 16 + l15; const float v = (sb <= pb && s <= p) ? a4[i] : 0.f;
                        *(LAS unsigned short*)(lds + GL_PP + p * 144 + s * 2) = f2bf(v); } }
                LDS_BARRIER();
#pragma unroll
                for (int dvl = 0; dvl < 4; ++dvl) { const int dvb = 4 * (w & 1) + dvl; f32x4 o4 = {0.f, 0.f, 0.f, 0.f};
                    o4 = mm16(lds + GL_PP + pb * 16 * 144, 144, lds + GL_VT + dvb * 16 * 144, 144, 2, o4, l15, quad);
                    o4 = mm16(lds + GL_QS + pb * 16 * 272, 272, lds + GL_ST + dvb * 16 * 272, 272, 4, o4, l15, quad);
#pragma unroll
                    for (int i = 0; i < 4; ++i) { const int p = pb * 16 + quad * 4 + i; const int tok = d == 0 ? R0 + 64 * cc + p : R0 + 255 - 64 * cc - p;
                        OD[(size_t)tok * DM + h * 128 + dvb * 16 + l15] = f2bf(o4[i]); } }
            }
#pragma unroll
            for (int j = 0; j < 8; ++j) { const float dd = DVEC[16 * j + l15]; sacc[j] = sacc[j] * dd;
                sacc[j] = mm16(lds + GL_VT + w * 16 * 144, 144, lds + GL_KST + j * 16 * 144, 144, 2, sacc[j], l15, quad); }
            if (PASS == 2) {
                LDS_BARRIER();
#pragma unroll
                for (int j = 0; j < 8; ++j)
#pragma unroll
                    for (int i = 0; i < 4; ++i) *(LAS unsigned short*)(lds + GL_ST + (16 * w + quad * 4 + i) * 272 + (16 * j + l15) * 2) = f2bf(sacc[j][i]);
            }
            LDS_BARRIER();
        }
        if (PASS == 1) {
            float* sp = ST + (size_t)item * 16384;
#pragma unroll
            for (int j = 0; j < 8; ++j)
#pragma unroll
                for (int i = 0; i < 4; ++i) sp[(16 * w + quad * 4 + i) * 128 + 16 * j + l15] = sacc[j][i];
            if (seg == 0) DVG[(size_t)item * 128 + dk] = fexp(ctotal);
        }
    }
}
__device__ __forceinline__ void gla_prop(float* ST, const float* __restrict__ DVG, int gt, int NGT) {
    for (int id = gt; id < 64 * 4096; id += NGT) {
        const int bdh = id >> 12, e = (id & 4095) * 4; f32x4 S = {0.f, 0.f, 0.f, 0.f};
        for (int s0 = 0; s0 < 65; s0 += 13) { f32x4 t[13], dd[13];
#pragma unroll
            for (int k = 0; k < 13; ++k) { const size_t idx = (size_t)bdh * 65 + s0 + k; t[k] = *(const f32x4*)(ST + idx * 16384 + e); dd[k] = *(const f32x4*)(DVG + idx * 128 + (e & 127)); }
#pragma unroll
            for (int k = 0; k < 13; ++k) { const size_t idx = (size_t)bdh * 65 + s0 + k; *(f32x4*)(ST + idx * 16384 + e) = S; S = dd[k] * S + t[k]; } }
    }
}
namespace att {
using s16x4  = __attribute__((ext_vector_type(4))) short;
using f32x16 = __attribute__((ext_vector_type(16))) float;
constexpr int NW = 8, QBLK = 32, KVBLK = 64;
#define ATT_SBAR() __builtin_amdgcn_sched_barrier(0)
__device__ __forceinline__ int crow(int r, int hi) { return (r & 3) + 8 * (r >> 2) + 4 * hi; }
__device__ __forceinline__ unsigned cvtpk(float lo, float hi) { unsigned r; asm volatile("v_cvt_pk_bf16_f32 %0, %1, %2" : "=v"(r) : "v"(lo), "v"(hi)); return r; }
__device__ __forceinline__ void partialSM(f32x16& p0, f32x16& p1, float& m_reg, float& mn, float& alpha, const float C, const float thr, const float fixref = 0.f) {
  float mnC;
  if (fixref > 0.f) {
    mn = m_reg; alpha = 1.f;
#pragma unroll
    for (int r = 0; r < 16; ++r) p0[r] = __builtin_amdgcn_exp2f(p0[r]);
    return;
  }
  {
  float pmax = p0[0];
#pragma unroll
  for (int r = 1; r < 16; ++r) pmax = fmaxf(pmax, p0[r]);
#pragma unroll
  for (int r = 0; r < 16; ++r) pmax = fmaxf(pmax, p1[r]);
  { auto rr = __builtin_amdgcn_permlane32_swap(__float_as_uint(pmax), __float_as_uint(pmax), false, false);
    pmax = fmaxf(__uint_as_float(rr[0]), __uint_as_float(rr[1])); }
  if (__builtin_expect(__all(pmax - m_reg <= thr), 1)) { mn = m_reg; alpha = 1.f; }
  else { mn = fmaxf(m_reg, pmax); alpha = __builtin_amdgcn_exp2f((m_reg - mn) * C); m_reg = mn; }
  mnC = -mn * C;
  }
#pragma unroll
  for (int r = 0; r < 16; ++r) p0[r] = fmaf(p0[r], C, mnC);
#pragma unroll
  for (int r = 0; r < 16; ++r) p1[r] = fmaf(p1[r], C, mnC);
#pragma unroll
  for (int r = 0; r < 16; ++r) p0[r] = __builtin_amdgcn_exp2f(p0[r]);
}
__device__ __forceinline__ void finishSM(f32x16& p0, f32x16& p1, float alpha, float& l_reg, bf16x8& pa0, bf16x8& pa1, bf16x8& pa2, bf16x8& pa3) {
#pragma unroll
  for (int r = 0; r < 16; ++r) p1[r] = __builtin_amdgcn_exp2f(p1[r]);
  float ps = 0;
#pragma unroll
  for (int r = 0; r < 16; ++r) ps += p0[r];
#pragma unroll
  for (int r = 0; r < 16; ++r) ps += p1[r];
  { auto rr = __builtin_amdgcn_permlane32_swap(__float_as_uint(ps), __float_as_uint(ps), false, false);
    ps = __uint_as_float(rr[0]) + __uint_as_float(rr[1]); }
  l_reg = l_reg * alpha + ps;
#define ATT_PK4(P, BASE, OUT) do { unsigned a0 = cvtpk(P[BASE + 0], P[BASE + 1]), a1 = cvtpk(P[BASE + 2], P[BASE + 3]);   \
    unsigned b0 = cvtpk(P[BASE + 4], P[BASE + 5]), b1 = cvtpk(P[BASE + 6], P[BASE + 7]);                              \
    auto r0 = __builtin_amdgcn_permlane32_swap(a0, b0, false, false); auto r1 = __builtin_amdgcn_permlane32_swap(a1, b1, false, false); \
    u32x4 w = {r0[0], r1[0], r0[1], r1[1]}; OUT = *reinterpret_cast<bf16x8*>(&w); } while (0)
  ATT_PK4(p0, 0, pa0); ATT_PK4(p0, 8, pa1); ATT_PK4(p1, 0, pa2); ATT_PK4(p1, 8, pa3);
#undef ATT_PK4
}
template <int DQK> __device__ __forceinline__ int kswz(int row, int colB) {
  if (DQK == 128) return row * 256 + (colB ^ ((row & 7) << 4));
  return row * 400 + colB;
}
template <int DQK> __device__ __forceinline__ void qkt(f32x16& p0, f32x16& p1, const char* Ks, const bf16x8* qr, int r32, int hi) {
  p0 = f32x16{}; p1 = f32x16{};
#pragma unroll
  for (int d0 = 0; d0 < DQK / 16; ++d0) { const int cb = (d0 * 16 + hi * 8) * 2;
    const bf16x8 b0 = *reinterpret_cast<const bf16x8*>(Ks + kswz<DQK>(r32, cb));
    const bf16x8 b1 = *reinterpret_cast<const bf16x8*>(Ks + kswz<DQK>(32 + r32, cb));
    p0 = __builtin_amdgcn_mfma_f32_32x32x16_bf16(b0, qr[d0], p0, 0, 0, 0);
    p1 = __builtin_amdgcn_mfma_f32_32x32x16_bf16(b1, qr[d0], p1, 0, 0, 0); }
}
__device__ __forceinline__ int v_st(int k, int c) { const int kk = (k & ~0xC) | ((k & 4) << 1) | ((k & 8) >> 1); return ((kk >> 3) * 4 + (c >> 5)) * 512 + ((kk & 7) * 32 + (c & 31)) * 2; }
__device__ __forceinline__ int v_rd_base(int lane) { return ((lane & 3) << 3) | (((lane >> 2) & 3) << 6) | (((lane >> 4) & 1) << 5) | (((lane >> 5) & 1) << 8); }
constexpr int v_rd_off(int d0, int ks, int half) { return d0 * 512 + ks * 4096 + half * 2048; }
template <int OFF> __device__ __forceinline__ s16x4 tr_read(int vb) { s16x4 r; asm volatile("ds_read_b64_tr_b16 %0, %1 offset:%2" : "=&v"(r) : "v"(vb), "i"(OFF) : "memory"); return r; }
template <int D0> __device__ __forceinline__ void pv_one(f32x16& od, int vb, bf16x8 pa0, bf16x8 pa1, bf16x8 pa2, bf16x8 pa3) {
  const s16x4 l0 = tr_read<v_rd_off(D0, 0, 0)>(vb), h0 = tr_read<v_rd_off(D0, 0, 1)>(vb), l1 = tr_read<v_rd_off(D0, 1, 0)>(vb), h1 = tr_read<v_rd_off(D0, 1, 1)>(vb);
  const s16x4 l2 = tr_read<v_rd_off(D0, 2, 0)>(vb), h2 = tr_read<v_rd_off(D0, 2, 1)>(vb), l3 = tr_read<v_rd_off(D0, 3, 0)>(vb), h3 = tr_read<v_rd_off(D0, 3, 1)>(vb);
  asm volatile("s_waitcnt lgkmcnt(0)" ::: "memory"); ATT_SBAR();
#define ATT_PK(L, H) (bf16x8){L[0], L[1], L[2], L[3], H[0], H[1], H[2], H[3]}
  od = __builtin_amdgcn_mfma_f32_32x32x16_bf16(pa0, ATT_PK(l0, h0), od, 0, 0, 0);
  od = __builtin_amdgcn_mfma_f32_32x32x16_bf16(pa1, ATT_PK(l1, h1), od, 0, 0, 0);
  od = __builtin_amdgcn_mfma_f32_32x32x16_bf16(pa2, ATT_PK(l2, h2), od, 0, 0, 0);
  od = __builtin_amdgcn_mfma_f32_32x32x16_bf16(pa3, ATT_PK(l3, h3), od, 0, 0, 0);
#undef ATT_PK
}
__device__ __forceinline__ void pv_d0(f32x16* o, int vb, bf16x8 pa0, bf16x8 pa1, bf16x8 pa2, bf16x8 pa3) {
  pv_one<0>(o[0], vb, pa0, pa1, pa2, pa3); pv_one<1>(o[1], vb, pa0, pa1, pa2, pa3); pv_one<2>(o[2], vb, pa0, pa1, pa2, pa3); pv_one<3>(o[3], vb, pa0, pa1, pa2, pa3);
}
template <int MODE> __device__ __forceinline__ void maskt(f32x16& p0, f32x16& p1, int t, int band0, int qpos, int hi) {
  if (MODE != 1) return;
  if (t < 4) return;
  const int pos0 = band0 + 64 * (t - 4);
#pragma unroll
  for (int r = 0; r < 16; ++r) { const int kp = pos0 + crow(r, hi); const int dq = qpos - kp, dq2 = dq - 32;
    const bool ok0 = (unsigned)kp < (unsigned)SEQ && dq <= 128 && dq >= -128; const bool ok1 = (unsigned)(kp + 32) < (unsigned)SEQ && dq2 <= 128 && dq2 >= -128;
    if (!ok0) p0[r] = -1e30f; if (!ok1) p1[r] = -1e30f; }
}
template <int DQK, int MODE>
__device__ __forceinline__ void attn_unit(const bf16* __restrict__ Qb, int ldq, const bf16* __restrict__ Kp, int ldk, const bf16* __restrict__ Vp, int ldv, bf16* __restrict__ Ob, int ldo,
                                          int NT, int ctx0, int lat0, int band0, int q0, float SCALE, float sinkL2, char* lds) {
  constexpr int SHM_V = KVBLK * 128 * 2, SHM_K = KVBLK * DQK * 2, CH = DQK / 8, NKC = DQK / 64, SDEPTH = (DQK > 128 ? 1 : 2);
  const float C = SCALE * LOG2E, thr = 8.f / SCALE;
  const int tid = threadIdx.x, wid = tid >> 6, lane = tid & 63, r32 = lane & 31, hi = lane >> 5;
  char* V_lds = lds; char* K_lds = lds + 2 * SHM_V;
  float* wsf = (float*)(lds + 2 * SHM_V + 2 * SHM_K) + wid * 64; float* li_l = wsf; float* al_l = wsf + 32;
  float m_reg = -1e30f, l_reg = 0; f32x16 o[4] = {}; bf16x8 qr[DQK / 16];
  const bf16* Qw = Qb + (long)(wid * QBLK + r32) * ldq + hi * 8;
#pragma unroll
  for (int d0 = 0; d0 < DQK / 16; ++d0) qr[d0] = *reinterpret_cast<const bf16x8*>(Qw + d0 * 16);
  const int sr = tid >> 4, sc = (tid & 15) * 8, vst0 = v_st(sr, sc), vst1 = v_st(32 + sr, sc);
  const int vb0 = (int)(uintptr_t)V_lds + v_rd_base(lane);
  int krow[NKC], kcol[NKC];
#pragma unroll
  for (int c = 0; c < NKC; ++c) { const int id = tid + 512 * c; krow[c] = id / CH; kcol[c] = id % CH; }
  struct { bf16x8 vs0, vs1, ks[NKC]; } sr_[SDEPTH];
  const int qpos = q0 + wid * QBLK + r32;
#define ATT_TROW(t) ((t) < 4 ? ctx0 + 64 * (t) : (MODE == 0 ? lat0 + 64 * ((t) - 4) : lat0 + min(max(band0 + 64 * ((t) - 4), 0), SEQ - 64)))
#define ATT_SLOAD(i, t) do { const long row0_ = ATT_TROW(t); sr_[i].vs0 = *reinterpret_cast<const bf16x8*>(&Vp[(row0_ + sr) * ldv + sc]); sr_[i].vs1 = *reinterpret_cast<const bf16x8*>(&Vp[(row0_ + 32 + sr) * ldv + sc]); \
    _Pragma("unroll") for (int c_ = 0; c_ < NKC; ++c_) sr_[i].ks[c_] = *reinterpret_cast<const bf16x8*>(&Kp[(row0_ + krow[c_]) * ldk + kcol[c_] * 8]); } while (0)
#define ATT_SWRITE(b, i) do { *(bf16x8*)(V_lds + (b) * SHM_V + vst0) = sr_[i].vs0; *(bf16x8*)(V_lds + (b) * SHM_V + vst1) = sr_[i].vs1; \
    _Pragma("unroll") for (int c_ = 0; c_ < NKC; ++c_) *(bf16x8*)(K_lds + (b) * SHM_K + kswz<DQK>(krow[c_], kcol[c_] * 16)) = sr_[i].ks[c_]; } while (0)
#define ATT_SWAIT() asm volatile("s_waitcnt vmcnt(%0)" :: "n"(SDEPTH == 2 ? 2 + NKC : 0) : "memory")
#define ATT_RESC(a) do { if (__any((a) < 1.f)) { if (hi == 0) al_l[r32] = (a); asm volatile("s_waitcnt lgkmcnt(0)" ::: "memory"); \
    _Pragma("unroll") for (int d = 0; d < 4; ++d) _Pragma("unroll") for (int r = 0; r < 16; ++r) o[d][r] *= al_l[crow(r, hi)]; } } while (0)
  f32x16 pA0, pA1, pB0, pB1; float mnA, mnB, alA, alB; bf16x8 pa0, pa1, pa2, pa3;
  constexpr int SE = 0, SO = SDEPTH - 1;
  ATT_SLOAD(SE, 0); asm volatile("s_waitcnt vmcnt(0)" ::: "memory"); ATT_SWRITE(0, SE); __syncthreads();
  qkt<DQK>(pA0, pA1, K_lds, qr, r32, hi); maskt<MODE>(pA0, pA1, 0, band0, qpos, hi); partialSM(pA0, pA1, m_reg, mnA, alA, C, thr);
  ATT_SLOAD(SO, 1); if constexpr (SDEPTH == 2) { if (2 < NT) ATT_SLOAD(SE, 2); }
  ATT_SWAIT(); ATT_SWRITE(1, SO); __syncthreads();
  for (int j = 1; j + 1 < NT; j += 2) {
    ATT_SBAR(); qkt<DQK>(pB0, pB1, K_lds + SHM_K, qr, r32, hi); maskt<MODE>(pB0, pB1, j, band0, qpos, hi);
    finishSM(pA0, pA1, alA, l_reg, pa0, pa1, pa2, pa3); ATT_SBAR();
    ATT_SLOAD(SO, j + SDEPTH); ATT_SBAR();
    pv_d0(o, vb0, pa0, pa1, pa2, pa3); partialSM(pB0, pB1, m_reg, mnB, alB, C, thr);
    __syncthreads(); ATT_SWAIT(); ATT_SWRITE(0, SE);
    ATT_RESC(alB); __syncthreads();
    ATT_SBAR(); qkt<DQK>(pA0, pA1, K_lds, qr, r32, hi); maskt<MODE>(pA0, pA1, j + 1, band0, qpos, hi);
    finishSM(pB0, pB1, alB, l_reg, pa0, pa1, pa2, pa3); ATT_SBAR();
    if (SDEPTH == 1 || j + 3 < NT) ATT_SLOAD(SE, j + 1 + SDEPTH); ATT_SBAR();
    pv_d0(o, vb0 + SHM_V, pa0, pa1, pa2, pa3); partialSM(pA0, pA1, m_reg, mnA, alA, C, thr);
    __syncthreads(); ATT_SWAIT(); ATT_SWRITE(1, SO);
    ATT_RESC(alA); __syncthreads();
  }
  ATT_SBAR(); qkt<DQK>(pB0, pB1, K_lds + SHM_K, qr, r32, hi); maskt<MODE>(pB0, pB1, NT - 1, band0, qpos, hi);
  finishSM(pA0, pA1, alA, l_reg, pa0, pa1, pa2, pa3); ATT_SBAR();
  pv_d0(o, vb0, pa0, pa1, pa2, pa3); partialSM(pB0, pB1, m_reg, mnB, alB, C, thr);
  __syncthreads(); ATT_RESC(alB);
  finishSM(pB0, pB1, alB, l_reg, pa0, pa1, pa2, pa3); ATT_SBAR();
  pv_d0(o, vb0 + SHM_V, pa0, pa1, pa2, pa3);
  if (MODE == 1) l_reg += __builtin_amdgcn_exp2f(sinkL2 - m_reg * C);
  if (hi == 0) li_l[r32] = l_reg; asm volatile("s_waitcnt lgkmcnt(0)" ::: "memory");
  float rli[16];
#pragma unroll
  for (int r = 0; r < 16; ++r) rli[r] = __builtin_amdgcn_rcpf(li_l[crow(r, hi)]);
  bf16* Ow = Ob + (long)(wid * QBLK) * ldo;
#pragma unroll
  for (int r = 0; r < 16; ++r) { const int orow = crow(r, hi);
#pragma unroll
    for (int d0 = 0; d0 < 4; ++d0) Ow[(long)orow * ldo + d0 * 32 + r32] = f2bf(o[d0][r] * rli[r]); }
  __syncthreads();
#undef ATT_TROW
#undef ATT_SLOAD
#undef ATT_SWRITE
#undef ATT_SWAIT
#undef ATT_RESC
}

template <int DQK, int MODE, bool EARLY, int QP = 0>
__device__ __forceinline__ void attn_unit_simple(const bf16* __restrict__ Qb, int ldq, const bf16* __restrict__ Kp, int ldk, const bf16* __restrict__ Vp, int ldv, bf16* __restrict__ Ob, int ldo,
                                                 int NT, int ctx0, int lat0, int band0, int q0, float SCALE, float sinkL2, char* lds, float fixref = 0.f,
                                                 const float* __restrict__ qkg = nullptr, const float* __restrict__ tab = nullptr, float qscale = 1.f, int qrow0 = 0) {
  constexpr int SHM_V = KVBLK * 128 * 2, SHM_K = KVBLK * (DQK == 128 ? 256 : 400), CH = DQK / 8, NKC = DQK / 64;
  const float C = SCALE * LOG2E, thr = 8.f / SCALE;
  int tid_ = threadIdx.x; asm volatile("" : "+v"(tid_));
  const int tid = tid_, wid = tid >> 6, lane = tid & 63, r32 = lane & 31, hi = lane >> 5;
  char* V_lds = lds; char* K_lds = lds + 2 * SHM_V;
  float* wsf = (float*)(lds + 2 * SHM_V + 2 * SHM_K) + wid * 64; float* li_l = wsf; float* al_l = wsf + 32;
  float m_reg = -1e30f, l_reg = 0; f32x16 o[4] = {}; bf16x8 qr[DQK / 16];
  const bf16* Qw = Qb + (long)(wid * QBLK + r32) * ldq + hi * 8;
#pragma unroll
  for (int d0 = 0; d0 < DQK / 16; ++d0) qr[d0] = *reinterpret_cast<const bf16x8*>(Qw + d0 * 16);
  const int sr = tid >> 4, sc = (tid & 15) * 8, vst0 = v_st(sr, sc), vst1 = v_st(32 + sr, sc);
  const int vb0 = (int)(uintptr_t)V_lds + v_rd_base(lane);
  int krow[NKC], kcol[NKC];
#pragma unroll
  for (int c = 0; c < NKC; ++c) { const int id = tid + 512 * c; krow[c] = id / CH; kcol[c] = id % CH; }
  bf16x8 vs0, vs1, ksg[NKC];
  const int qpos = q0 + wid * QBLK + r32;
#define ATT_TROW(t) ((t) < 4 ? ctx0 + 64 * (t) : (MODE == 0 ? lat0 + 64 * ((t) - 4) : lat0 + min(max(band0 + 64 * ((t) - 4), 0), SEQ - 64)))
#define ATT_SLOAD(t) do { const long row0_ = ATT_TROW(t); vs0 = *reinterpret_cast<const bf16x8*>(&Vp[(row0_ + sr) * ldv + sc]); vs1 = *reinterpret_cast<const bf16x8*>(&Vp[(row0_ + 32 + sr) * ldv + sc]); \
    _Pragma("unroll") for (int c_ = 0; c_ < NKC; ++c_) ksg[c_] = *reinterpret_cast<const bf16x8*>(&Kp[(row0_ + krow[c_]) * ldk + kcol[c_] * 8]); } while (0)
#define ATT_SWRITE(b) do { *(bf16x8*)(V_lds + (b) * SHM_V + vst0) = vs0; *(bf16x8*)(V_lds + (b) * SHM_V + vst1) = vs1; \
    _Pragma("unroll") for (int c_ = 0; c_ < NKC; ++c_) *(bf16x8*)(K_lds + (b) * SHM_K + kswz<DQK>(krow[c_], kcol[c_] * 16)) = ksg[c_]; } while (0)
  ATT_SLOAD(0);
  if constexpr (QP == 1) {
    int hi8 = hi * 8; asm volatile("" : "+v"(hi8));
    float sn_ = 0.f, sr_ = 0.f;
#pragma unroll
    for (int d0 = 0; d0 < 12; ++d0) { float f[8]; unpack8(__builtin_bit_cast(u32x4, qr[d0]), f);
#pragma unroll
      for (int e = 0; e < 8; ++e) { if (d0 < 8) sn_ += f[e] * f[e]; else sr_ += f[e] * f[e]; } }
    { auto r0_ = __builtin_amdgcn_permlane32_swap(__float_as_uint(sn_), __float_as_uint(sn_), false, false); sn_ = __uint_as_float(r0_[0]) + __uint_as_float(r0_[1]);
      auto r1_ = __builtin_amdgcn_permlane32_swap(__float_as_uint(sr_), __float_as_uint(sr_), false, false); sr_ = __uint_as_float(r1_[0]) + __uint_as_float(r1_[1]); }
    const float rn = frsq(sn_ * (1.f / 128.f) + EPS), rr = frsq(sr_ * (1.f / 64.f) + EPS);
#pragma unroll
    for (int d0 = 0; d0 < 8; ++d0) { float f[8]; unpack8(__builtin_bit_cast(u32x4, qr[d0]), f); const float* gp = qkg + 16 * d0 + hi8; const f32x4 g0 = *(const f32x4*)gp, g1 = *(const f32x4*)(gp + 4);
#pragma unroll
      for (int e = 0; e < 4; ++e) { f[e] = f[e] * rn * (g0[e] * qscale); f[4 + e] = f[4 + e] * rn * (g1[e] * qscale); }
      qr[d0] = __builtin_bit_cast(bf16x8, pack8(f)); }
    const int m_ = qrow0 + wid * QBLK + r32; const bool isl = m_ < MLAT; const int t_ = m_ & (SEQ - 1);
#pragma unroll
    for (int blk = 0; blk < 2; ++blk) { float fa[8], fb[8]; unpack8(__builtin_bit_cast(u32x4, qr[8 + 2 * blk]), fa); unpack8(__builtin_bit_cast(u32x4, qr[9 + 2 * blk]), fb);
      const float* ga = qkg + 128 + 32 * blk + hi8; const int pos = blk == 0 ? (t_ >> 6) : (t_ & 63);
      const float* tc = tab + (blk == 0 ? T_MC_R : T_MC_C) + pos * 16 + hi8; const float* ts = tab + (blk == 0 ? T_MS_R : T_MS_C) + pos * 16 + hi8;
      const f32x4 gA[2] = {((const f32x4*)ga)[0], ((const f32x4*)ga)[1]}, gB[2] = {((const f32x4*)(ga + 16))[0], ((const f32x4*)(ga + 16))[1]};
      const f32x4 cv[2] = {((const f32x4*)tc)[0], ((const f32x4*)tc)[1]}, sv[2] = {((const f32x4*)ts)[0], ((const f32x4*)ts)[1]};
#pragma unroll
      for (int e = 0; e < 8; ++e) { const float ya = fa[e] * rr * (gA[e >> 2][e & 3] * qscale), yb = fb[e] * rr * (gB[e >> 2][e & 3] * qscale);
        const float cs = isl ? cv[e >> 2][e & 3] : 1.f, sn = isl ? sv[e >> 2][e & 3] : 0.f;
        fa[e] = ya * cs - yb * sn; fb[e] = ya * sn + yb * cs; }
      qr[8 + 2 * blk] = __builtin_bit_cast(bf16x8, pack8(fa)); qr[9 + 2 * blk] = __builtin_bit_cast(bf16x8, pack8(fb)); }
  }
  if constexpr (QP == 2) {
    int hi8 = hi * 8; asm volatile("" : "+v"(hi8));
    float ss_ = 0.f;
#pragma unroll
    for (int d0 = 0; d0 < 8; ++d0) { float f[8]; unpack8(__builtin_bit_cast(u32x4, qr[d0]), f);
#pragma unroll
      for (int e = 0; e < 8; ++e) ss_ += f[e] * f[e]; }
    { auto r0_ = __builtin_amdgcn_permlane32_swap(__float_as_uint(ss_), __float_as_uint(ss_), false, false); ss_ = __uint_as_float(r0_[0]) + __uint_as_float(r0_[1]); }
    const float rn = frsq(ss_ * (1.f / 128.f) + EPS);
    const int t_ = (qrow0 + wid * QBLK + r32) & (SEQ - 1);
#pragma unroll
    for (int blk = 0; blk < 2; ++blk) { const int pos = blk == 0 ? (t_ >> 6) : (t_ & 63);
#pragma unroll
      for (int dd = 0; dd < 2; ++dd) { float fa[8], fb[8]; unpack8(__builtin_bit_cast(u32x4, qr[4 * blk + dd]), fa); unpack8(__builtin_bit_cast(u32x4, qr[4 * blk + 2 + dd]), fb);
        const float* ga = qkg + 64 * blk + 16 * dd + hi8; const float* tc = tab + (blk == 0 ? T_SC_R : T_SC_C) + pos * 32 + 16 * dd + hi8; const float* ts = tab + (blk == 0 ? T_SS_R : T_SS_C) + pos * 32 + 16 * dd + hi8;
        const f32x4 gA[2] = {((const f32x4*)ga)[0], ((const f32x4*)ga)[1]}, gB[2] = {((const f32x4*)(ga + 32))[0], ((const f32x4*)(ga + 32))[1]};
        const f32x4 cv[2] = {((const f32x4*)tc)[0], ((const f32x4*)tc)[1]}, sv[2] = {((const f32x4*)ts)[0], ((const f32x4*)ts)[1]};
#pragma unroll
        for (int e = 0; e < 8; ++e) { const float ya = fa[e] * rn * (gA[e >> 2][e & 3] * qscale), yb = fb[e] * rn * (gB[e >> 2][e & 3] * qscale); const float cs = cv[e >> 2][e & 3], sn = sv[e >> 2][e & 3]; fa[e] = ya * cs - yb * sn; fb[e] = ya * sn + yb * cs; }
        qr[4 * blk + dd] = __builtin_bit_cast(bf16x8, pack8(fa)); qr[4 * blk + 2 + dd] = __builtin_bit_cast(bf16x8, pack8(fb)); } }
  }
  f32x16 p0, p1; float mn, al; bf16x8 pa0, pa1, pa2, pa3;
  ATT_SWRITE(0); if (EARLY && 1 < NT) ATT_SLOAD(1); __syncthreads();
  for (int t = 0; t < NT; ++t) {
    const int bsel = t & 1;
    ATT_SBAR();
    qkt<DQK>(p0, p1, K_lds + bsel * SHM_K, qr, r32, hi); maskt<MODE>(p0, p1, t, band0, qpos, hi);
    partialSM(p0, p1, m_reg, mn, al, C, thr, fixref); finishSM(p0, p1, al, l_reg, pa0, pa1, pa2, pa3);
    if (__any(al < 1.f)) { if (hi == 0) al_l[r32] = al; asm volatile("s_waitcnt lgkmcnt(0)" ::: "memory");
#pragma unroll
      for (int d = 0; d < 4; ++d)
#pragma unroll
        for (int r = 0; r < 16; ++r) o[d][r] *= al_l[crow(r, hi)]; }
    ATT_SBAR();
    if (!EARLY && t + 1 < NT) ATT_SLOAD(t + 1);
    if (EARLY && t + 1 < NT) { ATT_SWRITE(bsel ^ 1); if (t + 2 < NT) ATT_SLOAD(t + 2); }
    ATT_SBAR();
    pv_d0(o, vb0 + bsel * SHM_V, pa0, pa1, pa2, pa3);
    if (!EARLY && t + 1 < NT) ATT_SWRITE(bsel ^ 1);
    __syncthreads();
  }
  if (MODE == 1) l_reg += __builtin_amdgcn_exp2f(sinkL2 - (fixref > 0.f ? 0.f : m_reg * C));
  if (hi == 0) li_l[r32] = l_reg; asm volatile("s_waitcnt lgkmcnt(0)" ::: "memory");
  float rli[16];
#pragma unroll
  for (int r = 0; r < 16; ++r) rli[r] = __builtin_amdgcn_rcpf(li_l[crow(r, hi)]);
  bf16* Ow = Ob + (long)(wid * QBLK) * ldo;
  {
    char* Ost = lds + wid * 8192;
#pragma unroll
    for (int r = 0; r < 16; ++r) { const int orow = crow(r, hi);
#pragma unroll
      for (int d0 = 0; d0 < 4; ++d0) *(unsigned short*)(Ost + orow * 256 + (d0 * 32 + r32) * 2) = f2bf(o[d0][r] * rli[r]); }
    asm volatile("s_waitcnt lgkmcnt(0)" ::: "memory");
#pragma unroll
    for (int k = 0; k < 8; ++k) { const int pc = k * 64 + lane, row = pc >> 4, c = pc & 15;
      *(u32x4*)(Ow + (long)row * ldo + c * 8) = *(const u32x4*)(Ost + row * 256 + c * 16); }
  }
  __syncthreads();
#undef ATT_TROW
#undef ATT_SLOAD
#undef ATT_SWRITE
}
}

struct Args { const float* in[N_IN]; float* out; unsigned char* ws; int ph_lo, ph_hi; };
#ifdef PROBE_MODE
constexpr int N_PHASES = 40;
#else
constexpr int N_PHASES = 39;
#endif

__global__ void __launch_bounds__(NTHR, 2) fwd_kernel(Args args) {
    extern __shared__ __attribute__((aligned(16))) unsigned char lds_raw[];
    LAS unsigned char* lds = (LAS unsigned char*)lds_raw;
#define tid ((int)threadIdx.x)
#define lane ((int)(threadIdx.x & 63))
#define wave (__builtin_amdgcn_readfirstlane((int)(threadIdx.x >> 6)))
#define G ((int)gridDim.x)
#define bid ((int)blockIdx.x)
#define gw (bid * NWAVES + wave)
#define NGW (G * NWAVES)
#define gt (bid * NTHR + tid)
#define NGT (G * NTHR)
    unsigned char* ws = args.ws; const float* const* in = args.in;
    volatile LAS unsigned* MISC = (volatile LAS unsigned*)(lds + MISC_OFF);
    for (int u = tid; u < (LDS_BYTES - MISC_OFF) / 4; u += NTHR) ((LAS unsigned*)(lds + MISC_OFF))[u] = 0u;
    __syncthreads();
    const int lo = args.ph_lo, hi = args.ph_hi;
    const bool one_launch = (hi - lo) > 1;
    XcdBarrier bar; bar.bar = (unsigned*)(ws + WS_CTL) + CW_BAR; bar.x = 0; bar.st = MISC + 8;
    if (one_launch) bar = xcd_barrier_post((unsigned*)(ws + WS_CTL) + CW_BAR, MISC + 8);
#ifndef ONLY
#define ONLY -1
#endif
#define IN(k) ((ONLY < 0 || ONLY == (k)) && lo <= (k) && (k) < hi)
#ifndef DUP_MASK
#define DUP_MASK(k) 0
#endif
#define REP(k) for (int rep_ = 0; rep_ < 1 + (DUP_MASK(k)); ++rep_)
#define SEAM(k) do { if (IN(k) && IN((k) + 1)) xcd_barrier(bar); } while (0)
    float* xlat = args.out; float* xctx = (float*)(ws + WS_XC);
    const float* modv = (const float*)(ws + WS_MODV); const float* tab = (const float*)(ws + WS_TAB);
    bf16* Hb = (bf16*)(ws + WS_H);
    bf16* HID = (bf16*)(ws + B_HID);
#define scr ((LAS float*)(lds + wave * 16384))

#ifndef PG_ALIGN
#define PG_ALIGN true
#endif
#ifndef PG_SP2
#define PG_SP2 true
#endif
#define GEMM_STORE(Aptr, Wptr, Mr, Nn, Kk, Optr, ldc_, splitc, splits) GEMM_STORE_C(Aptr, Wptr, Mr, Nn, Kk, Optr, ldc_, splitc, splits, bid)
#define GEMM_STORE_C(Aptr, Wptr, Mr, Nn, Kk, Optr, ldc_, splitc, splits, cc_) do { pg8::Gemm g_{(const pg8::bf16_t*)(Aptr), (const pg8::bf16_t*)(Wptr), (Mr), (Nn), (Kk), (Kk)}; pg8::StaticOrder S_; S_.init((Mr), (Nn), G, (cc_), WGM_ST); \
        pg8::EpiBf16<0> E_{(pg8::bf16_t*)(Optr), (ldc_), nullptr, (splitc), (splits), 1.f}; pg8::gemm_phase<pg8::EpiBf16<0>, pg8::StaticOrder, PG_ALIGN, PG_SP2>(lds, g_, S_, E_); } while (0)
#define GEMM_RESID(Aptr, Wptr, Mr, Kk, srcl, layer, chunk, ksplit) do { \
        if ((Mr) > MLAT) { pg8::Gemm g_{(const pg8::bf16_t*)(Aptr), (const pg8::bf16_t*)(Wptr), MROWS, DM, (Kk) / (ksplit), (Kk)}; pg8::CtxSplitOrder S_{(ksplit), (Kk) / (ksplit), G, bid}; \
        pg8::EpiPartial E_{(float*)(ws + B_PART), (Kk) / (ksplit)}; pg8::gemm_phase<pg8::EpiPartial, pg8::CtxSplitOrder, PG_ALIGN, PG_SP2>(lds, g_, S_, E_); } \
        { pg8::Gemm g_{(const pg8::bf16_t*)(Aptr), (const pg8::bf16_t*)(Wptr), MLAT, DM, (Kk), (Kk)}; pg8::StaticOrder S_; S_.init(MLAT, DM, G, bid, WGM_RES, 0, (Kk) == FFH); \
        pg8::EpiResid E_{(srcl), xctx, xlat, xctx, modv + (size_t)(layer) * 3 * 12288 + (chunk) * DM}; pg8::gemm_phase<pg8::EpiResid, pg8::StaticOrder, PG_ALIGN, PG_SP2>(lds, g_, S_, E_); } } while (0)
#ifndef WGM_RES
#define WGM_RES 4
#endif
#ifndef WGM_ST
#define WGM_ST 4
#endif
#ifndef WGM_FUP
#define WGM_FUP 4
#endif
#define FFN_UP(Mr) do { pg8::Gemm g_{(const pg8::bf16_t*)Hb, (const pg8::bf16_t*)(ws + W_FUP), (Mr), 2 * FFH, DM, DM}; pg8::StaticOrder S_; S_.init((Mr), 2 * FFH, G, bid, WGM_FUP); \
        pg8::EpiSwiglu E_{(pg8::bf16_t*)HID, FFH}; pg8::gemm_phase<pg8::EpiSwiglu, pg8::StaticOrder, PG_ALIGN, PG_SP2>(lds, g_, S_, E_); } while (0)
#define NORM(srcl, srcc, layer, which, Mr, ns, pl, pch) norm_phase((srcl), (srcc), in[I_NORMG] + ((layer) * 2 + (which)) * DM, modv + (size_t)(layer) * 3 * 12288, (which), Hb, (Mr), gw, NGW, lane, \
        (ns) ? (const float*)(ws + B_PART) : nullptr, (ns), modv + (size_t)(pl) * 3 * 12288 + 2 * 12288 + (pch) * DM, xctx)

    if (IN(0)) REP(0) { prologue(in, ws, lds, bid, G, tid); } SEAM(0);
    if (IN(1)) REP(1) { NORM(in[I_X], in[I_CTX], 0, 0, MROWS, 0, 0, 0); } SEAM(1);
    if (IN(2)) REP(2) { GEMM_STORE(Hb, ws + W_RGWI, MROWS, 4096, DM, ws + B_GR, 4096, 0, 0); } SEAM(2);
    if (IN(3)) REP(3) { rglru_items<1>((const bf16*)(ws + B_GR), in[I_RGCW], in[I_RGCB], (const bf16*)(ws + W_RGG), in[I_RGGB], in[I_RGLAM], (float*)(ws + B_CARRY), nullptr, nullptr, lds, bid, G, tid); } SEAM(3);
    if (IN(4)) REP(4) { rglru_prop((const float*)(ws + B_CARRY), (float*)(ws + B_HIN), (LAS float*)lds, bid, G, tid); } SEAM(4);
    if (IN(5)) REP(5) { rglru_items<2>((const bf16*)(ws + B_GR), in[I_RGCW], in[I_RGCB], (const bf16*)(ws + W_RGG), in[I_RGGB], in[I_RGLAM], nullptr, (const float*)(ws + B_HIN), Hb, lds, bid, G, tid); } SEAM(5);
    if (IN(6)) { GEMM_RESID(Hb, ws + W_RGWO, MROWS, DM, in[I_X], 0, 2, 8); } SEAM(6);
    if (IN(7)) REP(7) { NORM(xlat, in[I_CTX], 0, 1, MROWS, 8, 0, 2); } SEAM(7);
    if (IN(8)) REP(8) { FFN_UP(MROWS); } SEAM(8);
    if (IN(9)) { GEMM_RESID(HID, ws + W_FDN, MROWS, FFH, xlat, 0, 5, 11); } SEAM(9);
    if (IN(10)) REP(10) { NORM(xlat, xctx, 1, 0, MROWS, 11, 0, 5); __syncthreads(); cvt_ffn(in[I_FFNWI], in[I_FFNWO], 1, ws, scr, gw, NGW, lane); } SEAM(10);
    if (IN(11)) REP(11) { GEMM_STORE(Hb, ws + W_HGWI, MROWS, 10240, DM, ws + B_HG, DM, DM, (size_t)MROWS * DM); } SEAM(11);
    if (IN(12)) REP(12) { gla_items<1>((const bf16*)(ws + B_HG), tab + T_LB, (float*)(ws + B_ST), (float*)(ws + B_DV), nullptr, nullptr, lds, bid, G, tid); } SEAM(12);
    if (IN(13)) { gla_prop((float*)(ws + B_ST), (const float*)(ws + B_DV), gt, NGT); } SEAM(13);
    if (IN(14)) REP(14) { gla_items<2>((const bf16*)(ws + B_HG), tab + T_LB, (float*)(ws + B_ST), (float*)(ws + B_DV), (bf16*)(ws + B_OF), (bf16*)(ws + B_OB), lds, bid, G, tid); } SEAM(14);
    if (IN(15)) REP(15) { gla_final((const bf16*)(ws + B_OF), (const bf16*)(ws + B_OB), (const bf16*)(ws + B_HG) + 4 * (size_t)MROWS * DM, in[I_HGGN], Hb, gw, NGW, lane); } SEAM(15);
    if (IN(16)) { GEMM_RESID(Hb, ws + W_HGWO, MROWS, DM, xlat, 1, 2, 8); } SEAM(16);
    if (IN(17)) REP(17) { NORM(xlat, xctx, 1, 1, MROWS, 8, 1, 2); } SEAM(17);
    if (IN(18)) REP(18) { FFN_UP(MROWS); } SEAM(18);
    if (IN(19)) { GEMM_RESID(HID, ws + W_FDN, MROWS, FFH, xlat, 1, 5, 11); } SEAM(19);
    if (IN(20)) REP(20) { NORM(xlat, xctx, 2, 0, MROWS, 11, 1, 5); __syncthreads(); cvt_ffn(in[I_FFNWI], in[I_FFNWO], 2, ws, scr, gw, NGW, lane); } SEAM(20);
    if (IN(21)) REP(21) { GEMM_STORE(Hb, ws + W_MLWI, MROWS, 1280, DM, ws + B_MLC, 1280, 0, 0); } SEAM(21);
    if (IN(22)) REP(22) { mla_prep1((const bf16*)(ws + B_MLC), in[I_MLQN], in[I_MLKVN], in[I_MLQKG], tab, (bf16*)(ws + B_CQN), (bf16*)(ws + B_CKVN), (bf16*)(ws + B_KR), gw, NGW, lane); } SEAM(22);
    if (IN(23)) REP(23) { GEMM_STORE(ws + B_CQN, ws + W_MLUQ, MROWS, 3072, 512, ws + B_Q, 3072, 0, 0); }
    if (IN(24)) REP(24) { GEMM_STORE_C(ws + B_CKVN, ws + W_MLUKV, MROWS, 4096, 512, ws + B_KV, 4096, 0, 0, (G & 15) == 0 ? (bid + G / 2) % G : bid); } SEAM(24);
    if (IN(25)) { mla_prep2((bf16*)(ws + B_Q), (const bf16*)(ws + B_KV), (const bf16*)(ws + B_KR), (bf16*)(ws + B_KN), in[I_MLQKG], tab, gw, NGW, lane, tab[T_MFIX] > 0.f ? 0.07216878364870322f * LOG2E : 1.f); } SEAM(25);
    if (IN(26)) REP(26) {
        const bf16* Q = (const bf16*)(ws + B_Q); const bf16* KN = (const bf16*)(ws + B_KN); const bf16* KV = (const bf16*)(ws + B_KV);
        const int nu = 2048 + 32;
        for (int i = 0; bid + i * G < nu; ++i) {
            const int u = bid + i * G; int bh, qb, NT, row0;
            if (u < 2048) { if (G == 256) { bh = (bid & 7) + 8 * (i >> 1); qb = (i & 1) * 32 + (bid >> 3); } else { bh = u >> 6; qb = u & 63; } NT = 260; row0 = (bh >> 4) * SEQ + qb * 256; }
            else { bh = u - 2048; NT = 4; row0 = MLAT + (bh >> 4) * CTXL; }
            const int b = bh >> 4, h = bh & 15;
            att::attn_unit_simple<192, 0, true, 1>(Q + (size_t)row0 * 3072 + h * 192, 3072, KN + h * 192, 3072, KV + h * 256 + 128, 4096, Hb + (size_t)row0 * DM + h * 128, DM, NT, MLAT + b * CTXL, b * SEQ, 0, 0, 0.07216878364870322f, 0.f, (char*)lds_raw, tab[T_MFIX],
                in[I_MLQKG], tab, tab[T_MFIX] > 0.f ? 0.07216878364870322f * LOG2E : 1.f, row0);
        }
    } SEAM(26);
    if (IN(27)) { GEMM_RESID(Hb, ws + W_MLWO, MROWS, DM, xlat, 2, 2, 8); } SEAM(27);
    if (IN(28)) REP(28) { NORM(xlat, xctx, 2, 1, MROWS, 8, 2, 2); } SEAM(28);
    if (IN(29)) REP(29) { FFN_UP(MROWS); } SEAM(29);
    if (IN(30)) { GEMM_RESID(HID, ws + W_FDN, MROWS, FFH, xlat, 2, 5, 11); } SEAM(30);
#ifdef JUNK_THIN
    if (IN(31)) {
        if (JUNK_THIN & 1) mla_prep2((bf16*)(ws + B_Q), (const bf16*)(ws + B_KV), (const bf16*)(ws + B_KR), (bf16*)(ws + B_KN), in[I_MLQKG], tab, gw, NGW, lane, tab[T_MFIX] > 0.f ? 0.07216878364870322f * LOG2E : 1.f);
        if (JUNK_THIN & 2) swa_prep((bf16*)(ws + B_KV), in[I_SWQKG], tab, gw, NGW, lane);
        if (JUNK_THIN & 4) gla_prop((float*)(ws + B_ST), (const float*)(ws + B_DV), gt, NGT);
        xcd_barrier(bar);
    }
#endif
    if (IN(31)) REP(31) { NORM(xlat, xctx, 3, 0, MROWS, 11, 2, 5); __syncthreads(); cvt_ffn(in[I_FFNWI], in[I_FFNWO], 3, ws, scr, gw, NGW, lane); } SEAM(31);
    if (IN(32)) REP(32) { GEMM_STORE(Hb, ws + W_SWWI, MROWS, 3072, DM, ws + B_QKV, 3072, 0, 0); } SEAM(32);
    if (IN(33)) { swa_prep((bf16*)(ws + B_QKV), in[I_SWQKG], tab, gw, NGW, lane); } SEAM(33);
    if (IN(34)) REP(34) {
        const bf16* QKV = (const bf16*)(ws + B_QKV);
        for (int u = bid; u < 2048; u += G) { const int b = u >> 10, h = (u >> 6) & 15, qb = u & 63, kvh = h >> 2; const int row0 = b * SEQ + qb * 256;
            att::attn_unit_simple<128, 1, true, 2>(QKV + (size_t)row0 * 3072 + h * 128, 3072, QKV + 2048 + kvh * 128, 3072, QKV + 2560 + kvh * 128, 3072, Hb + (size_t)row0 * DM + h * 128, DM, 12, MLAT + b * CTXL, b * SEQ, qb * 256 - 128, qb * 256,
                                   0.08838834764831845f, in[I_SWSINK][h] * LOG2E, (char*)lds_raw, tab[T_SFIX], in[I_SWQKG], tab, tab[T_SFIX] > 0.f ? 0.08838834764831845f * LOG2E : 1.f, row0); }
    } SEAM(34);
    if (IN(35)) { GEMM_RESID(Hb, ws + W_SWWO, MLAT, DM, xlat, 3, 2, 8); } SEAM(35);
    if (IN(36)) REP(36) { NORM(xlat, xctx, 3, 1, MLAT, 0, 0, 0); } SEAM(36);
    if (IN(37)) REP(37) { FFN_UP(MLAT); } SEAM(37);
    if (IN(38)) { GEMM_RESID(HID, ws + W_FDN, MLAT, FFH, xlat, 3, 5, 11); } SEAM(38);
#ifdef EXTRA_BARRIERS
    if (IN(38)) { for (int xb_ = 0; xb_ < EXTRA_BARRIERS; ++xb_) xcd_barrier(bar); }
#endif
#ifdef JUNK_GEMM
    {
        float* jl = (float*)(ws + WS_BIG + 400 * MiB); float* jc = jl + (size_t)MLAT * DM;
        { xcd_barrier(bar); pg8::Gemm g_{(const pg8::bf16_t*)(JUNK_A), (const pg8::bf16_t*)(JUNK_W), MROWS, DM, JUNK_K, JUNK_K}; pg8::StaticOrder S_; S_.init(MROWS, DM, G, bid);
            pg8::EpiResid E_{jl, jc, jl, jc, modv}; pg8::gemm_phase<pg8::EpiResid, pg8::StaticOrder, PG_ALIGN, PG_SP2>(lds, g_, S_, E_); }
    }
#endif
#ifdef PROBE_MODE
    if (IN(39)) {
        for (size_t i = gt; i < (size_t)MLAT * DM / 4; i += NGT) { const int row = (int)(i >> 9), c4 = (int)(i & 511) * 4; f32x4 v = ((f32x4*)xlat)[i];
            { const float d0 = PROBE_D(row, c4 + 0), d1 = PROBE_D(row, c4 + 1), d2 = PROBE_D(row, c4 + 2), d3 = PROBE_D(row, c4 + 3); v.x += d0; v.y += d1; v.z += d2; v.w += d3; }
            ((f32x4*)xlat)[i] = v; }
    }
#endif
#undef IN
#undef SEAM
#undef tid
#undef lane
#undef wave
#undef G
#undef bid
#undef gw
#undef NGW
#undef gt
#undef NGT
}

#ifndef MK_N_LAUNCHES
#define MK_N_LAUNCHES 1
#endif
extern "C" void kernel_launch(void* const* d_in, const int* in_sizes, int n_in, void* d_out, int out_size, void* d_ws, size_t ws_size, hipStream_t stream) {
    static int grid = 0;
    if (grid == 0) {
        if (n_in != N_IN || out_size != MLAT * DM || ws_size < (size_t)1532 * MiB) { fprintf(stderr, "kernel_launch: unexpected shapes: n_in %d out %d ws %zu (need %zu)\n", n_in, out_size, ws_size, (size_t)WS_END); grid = -1; return; }
        int dev = 0, cus = 0, per_cu = 0;
        if (hipGetDevice(&dev) != hipSuccess || hipDeviceGetAttribute(&cus, hipDeviceAttributeMultiprocessorCount, dev) != hipSuccess) { grid = -1; return; }
        if (hipFuncSetAttribute((const void*)fwd_kernel, hipFuncAttributeMaxDynamicSharedMemorySize, LDS_BYTES) != hipSuccess) { fprintf(stderr, "kernel_launch: hipFuncSetAttribute failed\n"); grid = -1; return; }
        if (hipOccupancyMaxActiveBlocksPerMultiprocessor(&per_cu, (const void*)fwd_kernel, NTHR, LDS_BYTES) != hipSuccess || per_cu < 1) fprintf(stderr, "kernel_launch: occupancy query reports %d\n", per_cu);
        (void)hipGetLastError();
        grid = cus;
    }
    if (grid < 0) return;
    if (hipMemsetAsync((char*)d_ws + WS_CTL, 0, CTL_ZERO_BYTES, stream) != hipSuccess) return;
    Args a{};
    for (int i = 0; i < N_IN; ++i) a.in[i] = (const float*)d_in[i];
    a.out = (float*)d_out; a.ws = (unsigned char*)d_ws;
    if (MK_N_LAUNCHES == 1) { a.ph_lo = 0; a.ph_hi = N_PHASES; hipLaunchKernelGGL(fwd_kernel, dim3(grid), dim3(NTHR), LDS_BYTES, stream, a); }
    else { for (int p = 0; p < N_PHASES; ++p) { a.ph_lo = p; a.ph_hi = p + 1; hipLaunchKernelGGL(fwd_kernel, dim3(grid), dim3(NTHR), LDS_BYTES, stream, a); } }
    const hipError_t le = hipPeekAtLastError();
    if (le != hipSuccess) fprintf(stderr, "kernel_launch: launch failed: %s\n", hipGetErrorName(le));
}
```

```cpp
#include <hip/hip_runtime.h>
#include <cstdio>
#include <cstdint>
namespace pg8 {
#define PG8_LAS __attribute__((address_space(3)))
typedef unsigned short bf16_t;
typedef short bf16x8 __attribute__((ext_vector_type(8)));
typedef float f32x4 __attribute__((ext_vector_type(4)));
typedef unsigned u32x4 __attribute__((ext_vector_type(4)));
constexpr int BM = 256, BK = 64, HALF = 128, HTB = HALF * BK * 2  , STAGE_BYTES = 8 * HTB, NXCD = 8;

__host__ __device__ __forceinline__ int lds_byte(int r, int c) { const int st = (r >> 4) * 2 + (c >> 5), rr = r & 15, cc = c & 31, ob = rr * 64 + cc * 2; return st * 1024 + (ob ^ (((ob >> 9) & 1) << 5)); }
__host__ __device__ __forceinline__ void stage_rc(int b, int& R, int& C) { const int st = b / 1024, sb = b % 1024, swz = sb ^ (((sb >> 9) & 1) << 5); R = (st >> 1) * 16 + swz / 64; C = (st & 1) * 32 + (swz % 64) / 2; }
__host__ __device__ __forceinline__ int perm32(int rho) { const int n = rho >> 4, i = rho & 15; return 8 * (i >> 2) + 4 * n + (i & 3); }

struct Unit { int pm, pn, ko; };
struct Gemm { const bf16_t* A; const bf16_t* Bt; int M, N, K, ld; };

struct StaticOrder {
    int nM, nN, nwg, G, c, WGM, pm0, rev;
    __host__ __device__ void init(int M, int N, int G_, int c_, int wgm_ = 4, int pm0_ = 0, int rev_ = 0) { nM = M / BM; nN = N / BM; nwg = nM * nN; G = G_; c = c_; WGM = wgm_; pm0 = pm0_; rev = rev_; }
    __host__ __device__ bool next(int i, Unit& u) const {
        const long L = (long)i * G + c; if (L >= nwg) return false;
        int wgid = (int)L; { const int q = nwg / NXCD, r = nwg % NXCD, xcd = wgid % NXCD; int off = wgid / NXCD; if (rev) off = (xcd < r ? q : q - 1) - off; wgid = (xcd < r ? xcd * (q + 1) : r * (q + 1) + (xcd - r) * q) + off; }
        const int nig = WGM * nN, gid = wgid / nig, fm = gid * WGM, gsz = (nM - fm) < WGM ? (nM - fm) : WGM;
        u.pm = pm0 + fm + ((wgid % nig) % gsz); u.pn = (wgid % nig) / gsz; u.ko = 0; return true;
    }
    __device__ __forceinline__ void a_ready(const Unit&) const {}
    __device__ __forceinline__ void done(const Unit&) const {}
};

__device__ __forceinline__ unsigned cvt_pk_bf16(float lo, float hi) { unsigned r; asm volatile("v_cvt_pk_bf16_f32 %0, %1, %2" : "=v"(r) : "v"(lo), "v"(hi)); return r; }
typedef float f32x2 __attribute__((ext_vector_type(2)));
__device__ __forceinline__ f32x2 gelu_pk(f32x2 v) {
    const f32x2 av = __builtin_elementwise_abs(v), d = av * 0.2316418882f + 1.0f;
    f32x2 t; t.x = __builtin_amdgcn_rcpf(d.x); t.y = __builtin_amdgcn_rcpf(d.y);
    f32x2 q = t * 0.5307027145f + (-0.7265760135f); q = q * t + 0.7107068705f; q = q * t + (-0.142248368f); q = q * t + 0.127414796f; q = q * t;
    const f32x2 s = (v * v) * (-0.72134752044f);
    f32x2 e; e.x = __builtin_amdgcn_exp2f(s.x); e.y = __builtin_amdgcn_exp2f(s.y);
    const f32x2 m = v * (q * e), r = v - m;
    f32x2 o; o.x = v.x < 0.f ? m.x : r.x; o.y = v.y < 0.f ? m.y : r.y; return o;
}

template <int ACT  > struct EpiBf16 {
    static constexpr bool PERM = true, AFTER_DRAIN = false; static_assert(ACT == 0 || ACT == 1, "EpiBf16: ACT is 0 (none) or 1 (gelu_pk)");
    bf16_t* O; int ldc; const float* bias; int split_cols; size_t split_stride; float scale0;
    __device__ __forceinline__ void operator()(const f32x4 (&acc)[2][2][4][2], const Unit& u, int wr, int wc, int fr, int fq) const {
        const int row0 = u.pm * BM + wr * 64 + fr; int colt = u.pn * BM; bf16_t* base = O;
        float sc = 1.f; if (split_cols) { const int t = colt / split_cols; base += (size_t)t * split_stride; colt -= t * split_cols; if (t == 0) sc = scale0; }
        const int col0 = colt + wc * 32 + 8 * fq, bcol0 = u.pn * BM + wc * 32 + 8 * fq;
        f32x4 bv[2][2];
#pragma unroll
        for (int bj = 0; bj < 2; ++bj)
#pragma unroll
            for (int n = 0; n < 2; ++n) bv[bj][n] = bias ? *(const f32x4*)(bias + bcol0 + bj * HALF + 4 * n) : (f32x4){0.f, 0.f, 0.f, 0.f};
#pragma unroll
        for (int ai = 0; ai < 2; ++ai)
#pragma unroll
            for (int m = 0; m < 4; ++m) { bf16_t* rowp = base + (size_t)(row0 + ai * HALF + m * 16) * ldc + col0;
#pragma unroll
                for (int bj = 0; bj < 2; ++bj) { f32x4 v0 = acc[ai][bj][m][0] + bv[bj][0], v1 = acc[ai][bj][m][1] + bv[bj][1];
                    if (ACT == 1) { f32x2 a = gelu_pk((f32x2){v0[0], v0[1]}), b = gelu_pk((f32x2){v0[2], v0[3]}), c = gelu_pk((f32x2){v1[0], v1[1]}), d = gelu_pk((f32x2){v1[2], v1[3]});
                        v0 = (f32x4){a.x, a.y, b.x, b.y}; v1 = (f32x4){c.x, c.y, d.x, d.y}; }
                    v0 = v0 * sc; v1 = v1 * sc; u32x4 w; w.x = cvt_pk_bf16(v0[0], v0[1]); w.y = cvt_pk_bf16(v0[2], v0[3]); w.z = cvt_pk_bf16(v1[0], v1[1]); w.w = cvt_pk_bf16(v1[2], v1[3]);
                    *(u32x4*)(rowp + bj * HALF) = w; } }
    }
};
struct EpiSwiglu {
    static constexpr bool PERM = true, AFTER_DRAIN = false;
    bf16_t* O; int ldc;
    __device__ __forceinline__ void operator()(const f32x4 (&acc)[2][2][4][2], const Unit& u, int wr, int wc, int fr, int fq) const {
        const int row0 = u.pm * BM + wr * 64 + fr; const int col0 = u.pn * HALF + wc * 32 + 8 * fq;
#pragma unroll
        for (int ai = 0; ai < 2; ++ai)
#pragma unroll
            for (int m = 0; m < 4; ++m) { bf16_t* rowp = O + (size_t)(row0 + ai * HALF + m * 16) * ldc + col0;
                float h[8];
#pragma unroll
                for (int n = 0; n < 2; ++n)
#pragma unroll
                    for (int e = 0; e < 4; ++e) { const float g = acc[ai][0][m][n][e], up = acc[ai][1][m][n][e];
                        h[n * 4 + e] = g * __builtin_amdgcn_rcpf(1.f + __builtin_amdgcn_exp2f(-1.4426950408889634f * g)) * up; }
                u32x4 w; w.x = cvt_pk_bf16(h[0], h[1]); w.y = cvt_pk_bf16(h[2], h[3]); w.z = cvt_pk_bf16(h[4], h[5]); w.w = cvt_pk_bf16(h[6], h[7]);
                *(u32x4*)rowp = w; }
    }
};
struct EpiResid {
    static constexpr bool PERM = false, AFTER_DRAIN = false;
    const float* src_lat; const float* src_ctx; float* dst_lat; float* dst_ctx; const float* gate;
    __device__ __forceinline__ void operator()(const f32x4 (&acc)[2][2][4][2], const Unit& u, int wr, int wc, int fr, int fq) const {
        const int r0 = u.pm * BM; const bool isl = r0 < 32768; const int ci = isl ? (r0 >> 14) : 2;
        const float* sp = isl ? src_lat + (size_t)r0 * 2048 : src_ctx + (size_t)(r0 - 32768) * 2048;
        float* dp = isl ? dst_lat + (size_t)r0 * 2048 : dst_ctx + (size_t)(r0 - 32768) * 2048;
        const float* gp = gate + ci * 12288;
        const int col0 = u.pn * BM + wc * 32 + 4 * fq;
        f32x4 gv[2][2];
#pragma unroll
        for (int bj = 0; bj < 2; ++bj)
#pragma unroll
            for (int n = 0; n < 2; ++n) gv[bj][n] = *(const f32x4*)(gp + col0 + bj * HALF + n * 16);
#pragma unroll
        for (int ai = 0; ai < 2; ++ai)
#pragma unroll
            for (int m = 0; m < 4; ++m) { const size_t off = (size_t)(wr * 64 + ai * HALF + m * 16 + fr) * 2048 + col0;
                f32x4 xv[2][2];
#pragma unroll
                for (int bj = 0; bj < 2; ++bj)
#pragma unroll
                    for (int n = 0; n < 2; ++n) xv[bj][n] = *(const f32x4*)(sp + off + bj * HALF + n * 16);
#pragma unroll
                for (int bj = 0; bj < 2; ++bj)
#pragma unroll
                    for (int n = 0; n < 2; ++n) *(f32x4*)(dp + off + bj * HALF + n * 16) = xv[bj][n] + gv[bj][n] * acc[ai][bj][m][n];
                if (m & 1) asm volatile("" ::: "memory"); }
    }
};

struct CtxSplitOrder {
    int S, klen, G, c;
    __device__ bool next(int i, Unit& u) const { const int L = i * G + c; if (L >= 16 * S) return false; const int t = L / S, kq = L - t * S; u.pm = 128 + (t >> 3); u.pn = t & 7; u.ko = kq * klen; return true; }
    __device__ __forceinline__ void a_ready(const Unit&) const {}
    __device__ __forceinline__ void done(const Unit&) const {}
};
struct EpiPartial {
    static constexpr bool PERM = false, AFTER_DRAIN = false;
    float* part; int klen;
    __device__ __forceinline__ void operator()(const f32x4 (&acc)[2][2][4][2], const Unit& u, int wr, int wc, int fr, int fq) const {
        float* dp = part + ((size_t)(u.ko / klen) * 512 + (size_t)(u.pm - 128) * BM) * 2048;
        const int col0 = u.pn * BM + wc * 32 + 4 * fq;
#pragma unroll
        for (int ai = 0; ai < 2; ++ai)
#pragma unroll
            for (int m = 0; m < 4; ++m) { const size_t off = (size_t)(wr * 64 + ai * HALF + m * 16 + fr) * 2048 + col0;
#pragma unroll
                for (int bj = 0; bj < 2; ++bj)
#pragma unroll
                    for (int n = 0; n < 2; ++n) *(f32x4*)(dp + off + bj * HALF + n * 16) = acc[ai][bj][m][n]; }
    }
};

struct CtxKVOrder {
    int S, klen, G, c;
    __device__ bool next(int i, Unit& u) const { const int L = i * G + c; if (L >= 8 * S) return false; const int t = L / S, kq = L - t * S; u.pm = 128 + (t >> 2); u.pn = 8 + (t & 3); u.ko = kq * klen; return true; }
    __device__ __forceinline__ void a_ready(const Unit&) const {}
    __device__ __forceinline__ void done(const Unit&) const {}
};
struct EpiPartialKV {
    static constexpr bool PERM = false, AFTER_DRAIN = false;
    float* part; int klen;
    __device__ __forceinline__ void operator()(const f32x4 (&acc)[2][2][4][2], const Unit& u, int wr, int wc, int fr, int fq) const {
        int frx = fr; asm volatile("" : "+v"(frx));
        float* dp = part + ((size_t)(u.ko / klen) * 512 + (size_t)(u.pm - 128) * BM) * 1024;
        const int col0 = (u.pn - 8) * BM + wc * 32 + 4 * fq;
#pragma unroll
        for (int ai = 0; ai < 2; ++ai)
#pragma unroll
            for (int m = 0; m < 4; ++m) { const size_t off = (size_t)(wr * 64 + ai * HALF + m * 16 + frx) * 1024 + col0;
#pragma unroll
                for (int bj = 0; bj < 2; ++bj)
#pragma unroll
                    for (int n = 0; n < 2; ++n) *(f32x4*)(dp + off + bj * HALF + n * 16) = acc[ai][bj][m][n]; }
    }
};

template <class Epi, class Sched, bool ALIGN_EPI = false, bool SP2 = false>
__device__ __forceinline__ void gemm_phase(PG8_LAS unsigned char* lds, const Gemm g, const Sched& S, const Epi& E) {
    int tid_ = threadIdx.x; asm volatile("" : "+v"(tid_));
    const int tid = tid_, wid = __builtin_amdgcn_readfirstlane(tid >> 6), lane = tid & 63, wr = wid >> 2, wc = wid & 3, fr = lane & 15, fq = lane >> 4;
    const int K = g.ld, nt = g.K / BK;
    unsigned voffA[2], voffB[2];
#pragma unroll
    for (int i = 0; i < 2; ++i) { int R, C; stage_rc(tid * 16 + i * 8192, R, C); const int Rb = Epi::PERM ? ((R & ~31) + perm32(R & 31)) : R;
        voffA[i] = (unsigned)(R * K + C) * 2u; voffB[i] = (unsigned)(Rb * K + C) * 2u; }
    const size_t kstep = (size_t)(BK * 2);
    const size_t hstep = (size_t)HALF * K * 2;
    const size_t tstep = 2 * hstep;
    const unsigned ldsw = (unsigned)wid * 1024u;
    const int aoff = lds_byte(wr * 64 + fr, fq * 8), boff = lds_byte(wc * 32 + fr, fq * 8);
#define PG8_SA(b, h) (((b) * 2 + (h)) * HTB)
#define PG8_SB(b, h) ((4 + (b) * 2 + (h)) * HTB)
#define PG8_STAGE(bufoff, gbase, voff) do { _Pragma("unroll") for (int _i = 0; _i < 2; ++_i) \
        __builtin_amdgcn_global_load_lds((const unsigned*)((const char*)(gbase) + (voff)[_i]), (PG8_LAS unsigned*)(lds + (bufoff) + ldsw + _i * 8192), 16, 0, 0); } while (0)
#define PG8_LDA(dst, b, h) do { _Pragma("unroll") for (int m = 0; m < 4; ++m) _Pragma("unroll") for (int k = 0; k < 2; ++k) dst[m][k] = *(const PG8_LAS bf16x8*)(lds + PG8_SA(b, h) + aoff + m * 2048 + k * 1024); } while (0)
#define PG8_LDB(dst, b, h) do { _Pragma("unroll") for (int n = 0; n < 2; ++n) _Pragma("unroll") for (int k = 0; k < 2; ++k) dst[n][k] = *(const PG8_LAS bf16x8*)(lds + PG8_SB(b, h) + boff + n * 2048 + k * 1024); } while (0)
#define PG8_MMA(ai, bj, At, Bt) do { __builtin_amdgcn_s_setprio(1); _Pragma("unroll") for (int m = 0; m < 4; ++m) _Pragma("unroll") for (int n = 0; n < 2; ++n) _Pragma("unroll") for (int k = 0; k < 2; ++k) \
        acc[ai][bj][m][n] = __builtin_amdgcn_mfma_f32_16x16x32_bf16(Bt[n][k], At[m][k], acc[ai][bj][m][n], 0, 0, 0); __builtin_amdgcn_s_setprio(0); } while (0)
#define PG8_WAIT_V(n) asm volatile("s_waitcnt vmcnt(" #n ")" ::: "memory")
#define PG8_WAIT_L(n) asm volatile("s_waitcnt lgkmcnt(" #n ")" ::: "memory")
#define PG8_BAR __builtin_amdgcn_s_barrier()
#define PG8_SCHED __builtin_amdgcn_sched_barrier(0)
    Unit cur, nxt; int ui = 0;
    if (!S.next(0, cur)) return;
    f32x4 acc[2][2][4][2];
#pragma unroll
    for (int a = 0; a < 2; ++a)
#pragma unroll
        for (int b = 0; b < 2; ++b)
#pragma unroll
            for (int m = 0; m < 4; ++m)
#pragma unroll
                for (int n = 0; n < 2; ++n) acc[a][b][m][n] = (f32x4){0.f, 0.f, 0.f, 0.f};
    bf16x8 At[4][2], B0[2][2], B1[2][2];
    const char* cA = (const char*)g.A + (size_t)cur.pm * tstep + (size_t)cur.ko * 2; const char* cB = (const char*)g.Bt + (size_t)cur.pn * tstep + (size_t)cur.ko * 2;
    S.a_ready(cur);
    if constexpr (SP2) {
        PG8_STAGE(PG8_SB(0, 0), cB, voffB); PG8_STAGE(PG8_SB(0, 1), cB + hstep, voffB); PG8_STAGE(PG8_SA(0, 0), cA, voffA); PG8_STAGE(PG8_SA(0, 1), cA + hstep, voffA);
        if (wr == 1) PG8_BAR;
        PG8_WAIT_V(2); PG8_BAR;
        PG8_STAGE(PG8_SB(1, 0), cB + kstep, voffB); PG8_STAGE(PG8_SA(1, 0), cA + kstep, voffA); PG8_STAGE(PG8_SB(1, 1), cB + hstep + kstep, voffB);
        PG8_WAIT_V(6); PG8_BAR;
    } else {
        PG8_STAGE(PG8_SB(0, 0), cB, voffB); PG8_STAGE(PG8_SA(0, 0), cA, voffA); PG8_STAGE(PG8_SB(0, 1), cB + hstep, voffB); PG8_STAGE(PG8_SA(0, 1), cA + hstep, voffA);
        if (wr == 1) PG8_BAR;
        PG8_WAIT_V(4); PG8_BAR;
        PG8_STAGE(PG8_SB(1, 0), cB + kstep, voffB); PG8_STAGE(PG8_SA(1, 0), cA + kstep, voffA); PG8_STAGE(PG8_SB(1, 1), cB + hstep + kstep, voffB);
        PG8_WAIT_V(6); PG8_BAR;
    }
    for (;;) {
        const bool has_next = S.next(ui + 1, nxt);
        const char* nA = has_next ? (const char*)g.A + (size_t)nxt.pm * tstep + (size_t)nxt.ko * 2 : cA; const char* nB = has_next ? (const char*)g.Bt + (size_t)nxt.pn * tstep + (size_t)nxt.ko * 2 : cB;
        for (int t = 0; t < nt; t += 2) {
            const bool last = (t == nt - 2);
            const char* a1 = cA + (size_t)(t + 1) * kstep;
            const char* a2 = last ? nA : cA + (size_t)(t + 2) * kstep; const char* b2 = last ? nB : cB + (size_t)(t + 2) * kstep;
            const char* a3 = a2 + kstep; const char* b3 = b2 + kstep;
            if (last && has_next) S.a_ready(nxt);
            if constexpr (SP2) {
            PG8_LDB(B0, 0, 0); PG8_LDB(B1, 0, 1); PG8_SCHED; PG8_LDA(At, 0, 0); PG8_STAGE(PG8_SA(1, 1), a1 + hstep, voffA);
            PG8_WAIT_V(8); PG8_WAIT_L(0); PG8_BAR; PG8_MMA(0, 0, At, B0); PG8_MMA(0, 1, At, B1); PG8_BAR; PG8_SCHED;
            PG8_LDA(At, 0, 1); PG8_STAGE(PG8_SB(0, 0), b2, voffB); PG8_STAGE(PG8_SB(0, 1), b2 + hstep, voffB); PG8_STAGE(PG8_SA(0, 0), a2, voffA);
            PG8_WAIT_V(8); PG8_WAIT_L(0); PG8_BAR; PG8_MMA(1, 0, At, B0); PG8_MMA(1, 1, At, B1); PG8_BAR; PG8_SCHED;
            PG8_LDB(B0, 1, 0); PG8_LDB(B1, 1, 1); PG8_SCHED; PG8_LDA(At, 1, 0); PG8_STAGE(PG8_SA(0, 1), a2 + hstep, voffA);
            PG8_WAIT_V(8); PG8_WAIT_L(0); PG8_BAR; PG8_MMA(0, 0, At, B0); PG8_MMA(0, 1, At, B1); PG8_BAR; PG8_SCHED;
            PG8_LDA(At, 1, 1); PG8_STAGE(PG8_SB(1, 0), b3, voffB); PG8_STAGE(PG8_SB(1, 1), b3 + hstep, voffB); PG8_STAGE(PG8_SA(1, 0), a3, voffA);
            PG8_WAIT_V(8); PG8_WAIT_L(0); PG8_BAR; PG8_MMA(1, 0, At, B0); PG8_MMA(1, 1, At, B1); PG8_BAR; PG8_SCHED;
            } else {
            PG8_LDB(B0, 0, 0); PG8_SCHED; PG8_LDA(At, 0, 0); PG8_STAGE(PG8_SA(1, 1), a1 + hstep, voffA);
            PG8_WAIT_L(8); PG8_BAR; PG8_WAIT_L(0); PG8_MMA(0, 0, At, B0); PG8_BAR; PG8_SCHED;
            PG8_LDB(B1, 0, 1); PG8_STAGE(PG8_SB(0, 0), b2, voffB);
            PG8_BAR; PG8_WAIT_L(0); PG8_MMA(0, 1, At, B1); PG8_BAR;
            PG8_LDA(At, 0, 1); PG8_STAGE(PG8_SA(0, 0), a2, voffA);
            PG8_BAR; PG8_WAIT_L(0); PG8_MMA(1, 0, At, B0); PG8_BAR; PG8_SCHED;
            PG8_STAGE(PG8_SB(0, 1), b2 + hstep, voffB);
            PG8_WAIT_V(6); PG8_BAR; PG8_MMA(1, 1, At, B1); PG8_BAR;
            PG8_LDB(B0, 1, 0); PG8_SCHED; PG8_LDA(At, 1, 0); PG8_STAGE(PG8_SA(0, 1), a2 + hstep, voffA);
            PG8_WAIT_L(8); PG8_BAR; PG8_WAIT_L(0); PG8_MMA(0, 0, At, B0); PG8_BAR; PG8_SCHED;
            PG8_LDB(B1, 1, 1); PG8_STAGE(PG8_SB(1, 0), b3, voffB);
            PG8_BAR; PG8_WAIT_L(0); PG8_MMA(0, 1, At, B1); PG8_BAR;
            PG8_LDA(At, 1, 1); PG8_STAGE(PG8_SA(1, 0), a3, voffA);
            PG8_BAR; PG8_WAIT_L(0); PG8_MMA(1, 0, At, B0); PG8_BAR; PG8_SCHED;
            PG8_STAGE(PG8_SB(1, 1), b3 + hstep, voffB);
            PG8_WAIT_V(6); PG8_BAR; PG8_MMA(1, 1, At, B1); PG8_BAR;
            }
        }
        if constexpr (ALIGN_EPI) { if (wr == 0) PG8_BAR; }
        if constexpr (!Epi::AFTER_DRAIN) { E(acc, cur, wr, wc, fr, fq); S.done(cur); }
        if (!has_next) break;
#pragma unroll
        for (int a = 0; a < 2; ++a)
#pragma unroll
            for (int b = 0; b < 2; ++b)
#pragma unroll
                for (int m = 0; m < 4; ++m)
#pragma unroll
                    for (int n = 0; n < 2; ++n) acc[a][b][m][n] = (f32x4){0.f, 0.f, 0.f, 0.f};
        cur = nxt; cA = nA; cB = nB; ++ui;
        if constexpr (ALIGN_EPI) { if (wr == 1) PG8_BAR; }
    }
    PG8_WAIT_V(0);
    if constexpr (!ALIGN_EPI) { if (wr == 0) PG8_BAR; }
    PG8_BAR;
    if constexpr (Epi::AFTER_DRAIN) { E.fused(acc, cur, wr, wc, fr, fq, lds, wid, lane); S.done(cur); }
#undef PG8_SA
#undef PG8_SB
#undef PG8_STAGE
#undef PG8_LDA
#undef PG8_LDB
#undef PG8_MMA
#undef PG8_WAIT_V
#undef PG8_WAIT_L
#undef PG8_BAR
#undef PG8_SCHED
}
}
#define LAS __attribute__((address_space(3)))
#define GAS __attribute__((address_space(1)))
typedef unsigned short bf16;
typedef short bf16x8 __attribute__((ext_vector_type(8)));
typedef float f32x4 __attribute__((ext_vector_type(4)));
typedef float f32x2 __attribute__((ext_vector_type(2)));
typedef unsigned u32x4 __attribute__((ext_vector_type(4)));
typedef unsigned u32x2 __attribute__((ext_vector_type(2)));
typedef __bf16 bf16x2_t __attribute__((ext_vector_type(2)));

constexpr int NWAVES = 8, NTHR = 512;
constexpr int DM = 2048, NBATCH = 2, SEQ = 16384, CTXL = 256, MLAT = NBATCH * SEQ, MCTX = NBATCH * CTXL, MROWS = MLAT + MCTX;
constexpr int FFH = 5632;
constexpr float EPS = 1e-6f;
constexpr float LOG2E = 1.4426950408889634f;
constexpr size_t MiB = 1u << 20;
enum { I_X = 0, I_C, I_CTX, I_CCTX, I_MODW, I_MODB, I_NORMG, I_FFNWI, I_FFNWO, I_RGWI, I_RGCW, I_RGCB, I_RGGW, I_RGGB, I_RGLAM, I_RGWO,
       I_HGWI, I_HGLB, I_HGGN, I_HGWO, I_MLWI, I_MLQN, I_MLKVN, I_MLUQ, I_MLUKV, I_MLQKG, I_MLWO, I_SWWI, I_SWQKG, I_SWSINK, I_SWWO, N_IN };
constexpr size_t WS_CTL = 0, CTL_ZERO_BYTES = 64 * 1024;
constexpr size_t WS_MODV = 1 * MiB;
constexpr size_t WS_TAB = 2 * MiB;
constexpr size_t WS_XC = 4 * MiB;
constexpr size_t WS_W = 8 * MiB;
constexpr size_t W_RGWI = WS_W, W_RGG = W_RGWI + 16 * MiB, W_RGWO = W_RGG + 2 * MiB, W_HGWI = W_RGWO + 8 * MiB, W_HGWO = W_HGWI + 40 * MiB,
                 W_MLWI = W_HGWO + 8 * MiB, W_MLUQ = W_MLWI + 5 * MiB, W_MLUKV = W_MLUQ + 3 * MiB, W_MLWO = W_MLUKV + 4 * MiB,
                 W_SWWI = W_MLWO + 8 * MiB, W_SWWO = W_SWWI + 12 * MiB, W_FUP = W_SWWO + 8 * MiB, W_FDN = W_FUP + 44 * MiB, W_END = W_FDN + 22 * MiB;
static_assert(W_END == 188 * MiB, "weights map");
constexpr size_t WS_H = 188 * MiB;
constexpr size_t WS_BIG = 318 * MiB;
static_assert(WS_H + (size_t)MROWS * DM * 2 <= WS_BIG, "H");
constexpr size_t B_HID = WS_BIG;
constexpr size_t B_GR = WS_BIG;
constexpr size_t B_CARRY = WS_BIG + 264 * MiB;
constexpr size_t B_HIN = B_CARRY + 20 * MiB;
constexpr size_t SEC = (size_t)MROWS * DM * 2;
constexpr size_t B_HG = WS_BIG;
constexpr size_t B_ST = WS_BIG + 5 * SEC;
constexpr size_t B_DV = B_ST + (size_t)4160 * 65536;
constexpr size_t B_OF = B_DV + 4 * MiB;
constexpr size_t B_OB = B_OF + SEC;
constexpr size_t B_MLC = WS_BIG;
constexpr size_t B_CQN = B_MLC + 82 * MiB;
constexpr size_t B_CKVN = B_CQN + 33 * MiB;
constexpr size_t B_KR = B_CKVN + 33 * MiB;
constexpr size_t B_Q = B_KR + 5 * MiB;
constexpr size_t B_KV = B_Q + 196 * MiB;
constexpr size_t B_KN = B_KV + 261 * MiB;
constexpr size_t B_QKV = WS_BIG;
constexpr size_t B_PART = WS_BIG + 1170 * MiB;
constexpr size_t WS_END = (size_t)1536 * MiB;
static_assert(B_OB + SEC <= WS_END && B_KN + 196 * MiB <= WS_END && B_HID + (size_t)MROWS * FFH * 2 <= WS_END, "workspace map");
constexpr int T_MC_R = 0, T_MS_R = T_MC_R + 256 * 16, T_MC_C = T_MS_R + 256 * 16, T_MS_C = T_MC_C + 64 * 16,
              T_SC_R = T_MS_C + 64 * 16, T_SS_R = T_SC_R + 256 * 32, T_SC_C = T_SS_R + 256 * 32, T_SS_C = T_SC_C + 64 * 32,
              T_LB = T_SS_C + 64 * 32, T_MFIX = T_LB + 2 * 2048, T_SFIX = T_MFIX + 1, T_END = T_MFIX + 4;
constexpr int CW_BAR = 1024;
constexpr int RING_BYTES = 139264, MISC_OFF = RING_BYTES, LDS_BYTES = 147456;

#define LDS_WAIT() asm volatile("s_waitcnt lgkmcnt(0)" ::: "memory")
#define VM_WAIT() asm volatile("s_waitcnt vmcnt(0)" ::: "memory")
__device__ __forceinline__ float bf2f(unsigned short h) { return __uint_as_float((unsigned)h << 16); }
__device__ __forceinline__ float bflo(unsigned w) { return __uint_as_float(w << 16); }
__device__ __forceinline__ float bfhi(unsigned w) { return __uint_as_float(w & 0xffff0000u); }
__device__ __forceinline__ unsigned pk2(float lo, float hi) { f32x2 v = {lo, hi}; bf16x2_t b = __builtin_convertvector(v, bf16x2_t); return __builtin_bit_cast(unsigned, b); }
__device__ __forceinline__ unsigned short f2bf(float f) { return (unsigned short)(pk2(f, 0.f) & 0xffffu); }
__device__ __forceinline__ float fexp(float x) { return __builtin_amdgcn_exp2f(x * LOG2E); }
__device__ __forceinline__ float flog(float x) { return __builtin_amdgcn_logf(x) * 0.6931471805599453f; }
__device__ __forceinline__ float frcp(float x) { return __builtin_amdgcn_rcpf(x); }
__device__ __forceinline__ float sigm(float x) { return frcp(1.f + fexp(-x)); }
__device__ __forceinline__ float silu(float x) { return x * sigm(x); }
__device__ __forceinline__ float frsq(float x) { return __builtin_amdgcn_rsqf(x); }
__device__ __forceinline__ float wave_sum(float v) {
#pragma unroll
    for (int o = 1; o < 64; o <<= 1) v += __shfl_xor(v, o);
    return v;
}
__device__ __forceinline__ float quad_sum(float v) { v += __shfl_xor(v, 1); v += __shfl_xor(v, 2); return v; }
__device__ __forceinline__ void unpack8(const u32x4 w, float (&f)[8]) {
    f[0] = bflo(w.x); f[1] = bfhi(w.x); f[2] = bflo(w.y); f[3] = bfhi(w.y); f[4] = bflo(w.z); f[5] = bfhi(w.z); f[6] = bflo(w.w); f[7] = bfhi(w.w);
}
__device__ __forceinline__ u32x4 pack8(const float (&f)[8]) { u32x4 w; w.x = pk2(f[0], f[1]); w.y = pk2(f[2], f[3]); w.z = pk2(f[4], f[5]); w.w = pk2(f[6], f[7]); return w; }

__device__ __forceinline__ void cvt_item(const float* W, int ldw, bf16* dst, int ldd, LAS float* scr, int lane) {
#pragma unroll 8
    for (int i = 0; i < 32; ++i) { const int kk = 2 * i + (lane >> 5); scr[kk * 33 + (lane & 31)] = W[(size_t)kk * ldw + (lane & 31)]; }
    LDS_WAIT(); asm volatile("" ::: "memory");
    const int c = lane & 7;
#pragma unroll
    for (int j = 0; j < 4; ++j) { const int n = (lane >> 3) + 8 * j; const LAS float* s = scr + (8 * c) * 33 + n;
        u32x4 o; o.x = pk2(s[0 * 33], s[1 * 33]); o.y = pk2(s[2 * 33], s[3 * 33]); o.z = pk2(s[4 * 33], s[5 * 33]); o.w = pk2(s[6 * 33], s[7 * 33]);
        *(GAS u32x4*)(dst + (size_t)n * ldd + 8 * c) = o; }
    LDS_WAIT(); asm volatile("" ::: "memory");
}
template <int MAP> __device__ __forceinline__ void cvt_matrix(const float* W, int K, int N, bf16* D, LAS float* scr, int gw, int NGW, int lane) {
    const int nblk = N / 32, items = (K / 64) * nblk;
    for (int it = gw; it < items; it += NGW) {
        const int kb = it / nblk, nb = it - kb * nblk, n0 = 32 * nb, k0 = 64 * kb;
        int drow = n0;
        if (MAP == 1) { const int up = n0 >= FFH; const int nn = up ? n0 - FFH : n0; drow = 256 * (nn >> 7) + (up ? 128 : 0) + (nn & 127); }
        cvt_item(W + (size_t)k0 * N + n0, N, D + (size_t)drow * K + k0, K, scr, lane);
    }
}
__device__ __forceinline__ void cvt_ffn(const float* wi, const float* wo, int layer, unsigned char* ws, LAS float* scr, int gw, int NGW, int lane) {
    cvt_matrix<1>(wi + (size_t)layer * DM * 2 * FFH, DM, 2 * FFH, (bf16*)(ws + W_FUP), scr, gw, NGW, lane);
    cvt_matrix<0>(wo + (size_t)layer * FFH * DM, FFH, DM, (bf16*)(ws + W_FDN), scr, gw, NGW, lane);
}
__device__ __forceinline__ void sincos_d(float a, float& s, float& c) {
    const double TWO_PI = 6.283185307179586476925286766559, INV_2PI = 0.15915494309189533576888376337251;
    double t = (double)a * INV_2PI; t -= __builtin_rint(t); const double r = t * TWO_PI, r2 = r * r;
    double ts = r, ss = r, tc = 1.0, cc = 1.0;
    for (int n = 1; n <= 15; ++n) { ts *= -r2 / (double)((2 * n) * (2 * n + 1)); ss += ts; tc *= -r2 / (double)((2 * n - 1) * (2 * n)); cc += tc; }
    s = (float)ss; c = (float)cc;
}
__device__ __forceinline__ void prologue(const float* const* in, unsigned char* ws, LAS unsigned char* lds, int bid, int G, int tid) {
    const int lane = tid & 63, wave = tid >> 6, gw = bid * NWAVES + wave, NGW = G * NWAVES, gt = bid * NTHR + tid, NGT = G * NTHR;
    LAS float* scr = (LAS float*)(lds + wave * 16384);
    cvt_matrix<0>(in[I_RGWI], DM, 4096, (bf16*)(ws + W_RGWI), scr, gw, NGW, lane);
    for (int it = gw; it < 512; it += NGW) {
        const int mtx = it >> 3, sub = it & 7, dg = mtx >> 4, k = mtx & 15, kb = sub >> 2, nb = sub & 3;
        const float* W = in[I_RGGW] + (size_t)mtx * 16384; bf16* D = (bf16*)(ws + W_RGG) + ((size_t)k * 512 + dg * 128) * 128;
        cvt_item(W + (size_t)(64 * kb) * 128 + 32 * nb, 128, D + (size_t)(32 * nb) * 128 + 64 * kb, 128, scr, lane);
    }
    cvt_matrix<0>(in[I_RGWO], DM, DM, (bf16*)(ws + W_RGWO), scr, gw, NGW, lane);
    cvt_matrix<0>(in[I_HGWI], DM, 10240, (bf16*)(ws + W_HGWI), scr, gw, NGW, lane);
    cvt_matrix<0>(in[I_HGWO], DM, DM, (bf16*)(ws + W_HGWO), scr, gw, NGW, lane);
    cvt_matrix<0>(in[I_MLWI], DM, 1088, (bf16*)(ws + W_MLWI), scr, gw, NGW, lane);
    for (int i = gt; i < 192 * DM / 8; i += NGT) ((GAS u32x4*)((bf16*)(ws + W_MLWI) + (size_t)1088 * DM))[i] = (u32x4){0u, 0u, 0u, 0u};
    cvt_matrix<0>(in[I_MLUQ], 512, 3072, (bf16*)(ws + W_MLUQ), scr, gw, NGW, lane);
    cvt_matrix<0>(in[I_MLUKV], 512, 4096, (bf16*)(ws + W_MLUKV), scr, gw, NGW, lane);
    cvt_matrix<0>(in[I_MLWO], DM, DM, (bf16*)(ws + W_MLWO), scr, gw, NGW, lane);
    cvt_matrix<0>(in[I_SWWI], DM, 3072, (bf16*)(ws + W_SWWI), scr, gw, NGW, lane);
    cvt_matrix<0>(in[I_SWWO], DM, DM, (bf16*)(ws + W_SWWO), scr, gw, NGW, lane);
    cvt_ffn(in[I_FFNWI], in[I_FFNWO], 0, ws, scr, gw, NGW, lane);
    float* tab = (float*)(ws + WS_TAB);
    for (int i = gt; i < 320 * 16 + 320 * 32; i += NGT) {
        int nf, j, pos, isc; float* cdst; float* sdst;
        if (i < 320 * 16) { nf = 16; const int p = i >> 4; j = i & 15; isc = p >= 256; pos = isc ? p - 256 : p; cdst = tab + (isc ? T_MC_C : T_MC_R) + pos * 16 + j; sdst = tab + (isc ? T_MS_C : T_MS_R) + pos * 16 + j; }
        else { const int i2 = i - 320 * 16; nf = 32; const int p = i2 >> 5; j = i2 & 31; isc = p >= 256; pos = isc ? p - 256 : p; cdst = tab + (isc ? T_SC_C : T_SC_R) + pos * 32 + j; sdst = tab + (isc ? T_SS_C : T_SS_R) + pos * 32 + j; }
        const float inv = exp2f(-((float)j / (float)nf) * 13.287712379549449f);
        const float ang = (float)pos * inv; float s, c; sincos_d(ang, s, c); *cdst = c; *sdst = s;
    }
    for (int i = gt; i < 2 * 2048; i += NGT) {
        const float* lg = in[I_HGLB]; const float a0 = lg[i], a1 = lg[4096 + i], a2 = lg[8192 + i], a3 = lg[12288 + i];
        const float mx = fmaxf(fmaxf(a0, a1), fmaxf(a2, a3)); const float e0 = expf(a0 - mx), e1 = expf(a1 - mx), e2 = expf(a2 - mx), e3 = expf(a3 - mx);
        tab[T_LB + i] = e1 / (e0 + e1 + e2 + e3);
    }
    if (gw == 0) {
        const float* g = in[I_MLQKG];
        const float q0 = g[lane], q1 = g[64 + lane], q2 = g[128 + lane], k0 = g[192 + lane], k1 = g[256 + lane], k2 = g[320 + lane];
        float a0 = fmaxf(q0 * q0, q1 * q1), a1 = q2 * q2, b0 = fmaxf(k0 * k0, k1 * k1), b1 = k2 * k2;
#pragma unroll
        for (int m = 1; m < 64; m <<= 1) { a0 = fmaxf(a0, __shfl_xor(a0, m)); a1 = fmaxf(a1, __shfl_xor(a1, m)); b0 = fmaxf(b0, __shfl_xor(b0, m)); b1 = fmaxf(b1, __shfl_xor(b1, m)); }
        const float bound = sqrtf((128.f * a0 + 64.f * a1) * (128.f * b0 + 64.f * b1)) * 0.07216878364870322f * LOG2E;
        if (lane == 0) tab[T_MFIX] = (bound > 0.f && bound < 60.f) ? bound : 0.f;
        const float* gs = in[I_SWQKG]; const float s0 = gs[lane], s1 = gs[64 + lane], s2 = gs[128 + lane], s3 = gs[192 + lane];
        float c0 = fmaxf(s0 * s0, s1 * s1), c1 = fmaxf(s2 * s2, s3 * s3);
#pragma unroll
        for (int m = 1; m < 64; m <<= 1) { c0 = fmaxf(c0, __shfl_xor(c0, m)); c1 = fmaxf(c1, __shfl_xor(c1, m)); }
        const float bound2 = 128.f * sqrtf(c0 * c1) * 0.08838834764831845f * LOG2E;
        if (lane == 0) tab[T_SFIX] = (bound2 > 0.f && bound2 < 60.f) ? bound2 : 0.f;
    }
    __syncthreads();
    LAS float* cond = (LAS float*)lds; LAS float* part = (LAS float*)(lds + 32768);
    for (int i = tid; i < 3 * DM; i += NTHR) { const float v = i < 2 * DM ? in[I_C][i] : in[I_CCTX][i - 2 * DM]; cond[i] = v / (1.f + expf(-v)); }
    __syncthreads();
    float* modv = (float*)(ws + WS_MODV);
    for (int it = bid; it < 4 * 192; it += G) {
        const int l = it / 192, n0 = (it - l * 192) * 64; const int kq = lane >> 4, c4 = lane & 15;
        f32x4 acc[3] = {{0.f, 0.f, 0.f, 0.f}, {0.f, 0.f, 0.f, 0.f}, {0.f, 0.f, 0.f, 0.f}};
        const float* wp = in[I_MODW] + ((size_t)l * DM + 256 * wave + kq) * 12288 + n0 + 4 * c4;
#pragma unroll 4
        for (int i = 0; i < 64; ++i) { const f32x4 wv = *(const f32x4*)(wp + (size_t)(4 * i) * 12288); const int k = 256 * wave + 4 * i + kq;
            acc[0] += cond[k] * wv; acc[1] += cond[DM + k] * wv; acc[2] += cond[2 * DM + k] * wv; }
#pragma unroll
        for (int ci = 0; ci < 3; ++ci)
#pragma unroll
            for (int e = 0; e < 4; ++e) { float v = acc[ci][e]; v += __shfl_xor(v, 16); v += __shfl_xor(v, 32); acc[ci][e] = v; }
        if (kq == 0) {
#pragma unroll
            for (int ci = 0; ci < 3; ++ci)
#pragma unroll
                for (int e = 0; e < 4; ++e) part[(wave * 3 + ci) * 64 + 4 * c4 + e] = acc[ci][e]; }
        __syncthreads();
        if (tid < 192) { const int ci = tid >> 6, cc = tid & 63; float s = in[I_MODB][l * 12288 + n0 + cc];
#pragma unroll
            for (int w = 0; w < 8; ++w) s += part[(w * 3 + ci) * 64 + cc];
            modv[(size_t)(l * 3 + ci) * 12288 + n0 + cc] = s; }
        __syncthreads();
    }
}

__device__ __forceinline__ void norm_phase(const float* xlat, const float* xctx, const float* g, const float* modv_l, int which, bf16* H, int mrows, int gw, int NGW, int lane,
                                           const float* part, int nsplit, const float* pgate, float* xctx_out) {
    for (int m = mrows - 1 - gw; m >= 0; m -= NGW) {
        const bool isl = m < MLAT; const int ci = isl ? (m >> 14) : 2;
        const float* xr = isl ? xlat + (size_t)m * DM : xctx + (size_t)(m - MLAT) * DM;
        const float* sh = modv_l + ci * 12288 + (which ? 3 : 0) * DM; const float* sc = sh + DM;
        f32x4 v[8]; float s = 0.f;
#pragma unroll
        for (int j = 0; j < 8; ++j) v[j] = ((const f32x4*)xr)[lane + 64 * j];
        if (!isl && part) {
#pragma unroll
            for (int j = 0; j < 8; ++j) { f32x4 a = {0.f, 0.f, 0.f, 0.f};
                for (int q = 0; q < nsplit; ++q) a += ((const f32x4*)(part + ((size_t)q * 512 + (m - MLAT)) * DM))[lane + 64 * j];
                v[j] += ((const f32x4*)pgate)[lane + 64 * j] * a; ((f32x4*)(xctx_out + (size_t)(m - MLAT) * DM))[lane + 64 * j] = v[j]; }
        }
#pragma unroll
        for (int j = 0; j < 8; ++j) s += (v[j].x * v[j].x + v[j].y * v[j].y) + (v[j].z * v[j].z + v[j].w * v[j].w);
        s = wave_sum(s); const float rstd = frsq(s * (1.f / DM) + EPS);
#pragma unroll
        for (int j = 0; j < 8; ++j) { const int c4 = lane + 64 * j; const f32x4 gg = ((const f32x4*)g)[c4], ss = ((const f32x4*)sc)[c4], hh = ((const f32x4*)sh)[c4];
            const f32x4 o = (v[j] * rstd) * gg * (1.f + ss) + hh; u32x2 w; w.x = pk2(o.x, o.y); w.y = pk2(o.z, o.w); ((u32x2*)(H + (size_t)m * DM))[c4] = w; }
    }
}
__device__ __forceinline__ void mla_prep1(const bf16* C, const float* qng, const float* kvng, const float* qkg, const float* tab, bf16* CQN, bf16* CKVN, bf16* KR, int gw, int NGW, int lane) {
    float g1[8], g2[8];
#pragma unroll
    for (int e = 0; e < 8; ++e) { g1[e] = qng[8 * lane + e]; g2[e] = kvng[8 * lane + e]; }
    const float gk = qkg[192 + 128 + lane];
    for (int m0 = gw; m0 < MROWS; m0 += 2 * NGW) {
        const int m1 = m0 + NGW; const bool two = m1 < MROWS;
        u32x4 a[2], b[2]; float kr[2];
#pragma unroll
        for (int r = 0; r < 2; ++r) { const bf16* cr = C + (size_t)(r == 0 || two ? (r == 0 ? m0 : m1) : m0) * 1280;
            a[r] = *(const u32x4*)(cr + 8 * lane); b[r] = *(const u32x4*)(cr + 512 + 8 * lane); kr[r] = bf2f(cr[1024 + lane]); }
#pragma unroll
        for (int r = 0; r < 2; ++r) { if (r == 1 && !two) break; const int m = r == 0 ? m0 : m1;
            float fa[8], fb[8]; unpack8(a[r], fa); unpack8(b[r], fb); float sa = 0.f, sb = 0.f;
#pragma unroll
            for (int e = 0; e < 8; ++e) { sa += fa[e] * fa[e]; sb += fb[e] * fb[e]; }
            sa = wave_sum(sa); sb = wave_sum(sb); const float sk = wave_sum(kr[r] * kr[r]);
            const float ra = frsq(sa * (1.f / 512.f) + EPS), rb = frsq(sb * (1.f / 512.f) + EPS), rk = frsq(sk * (1.f / 64.f) + EPS);
#pragma unroll
            for (int e = 0; e < 8; ++e) { fa[e] = fa[e] * ra * g1[e]; fb[e] = fb[e] * rb * g2[e]; }
            *(u32x4*)(CQN + (size_t)m * 512 + 8 * lane) = pack8(fa); *(u32x4*)(CKVN + (size_t)m * 512 + 8 * lane) = pack8(fb);
            float y = kr[r] * rk * gk; const float py = __shfl_xor(y, 16);
            if (m < MLAT) { const int t = m & (SEQ - 1), j = lane & 15; const bool isr = lane < 32; const int pos = isr ? (t >> 6) : (t & 63);
                const float cs = tab[(isr ? T_MC_R : T_MC_C) + pos * 16 + j], sn = tab[(isr ? T_MS_R : T_MS_C) + pos * 16 + j];
                y = ((lane >> 4) & 1) ? py * sn + y * cs : y * cs - py * sn; }
            KR[(size_t)m * 64 + lane] = f2bf(y); }
    }
}
__device__ __forceinline__ void mla_prep2(bf16* Q, const bf16* KV, const bf16* KR, bf16* KN, const float* qkg, const float* tab, int gw, int NGW, int lane, const float qscale) {
    const int h = lane >> 2, s = lane & 3;
    float gkn[32];
#pragma unroll
    for (int i = 0; i < 32; ++i) gkn[i] = qkg[192 + 32 * s + i];
    for (int m = gw; m < MROWS; m += NGW) {
        float x[32];
        const bf16* kp = KV + (size_t)m * 4096 + h * 256 + 32 * s; bf16* kn = KN + (size_t)m * 3072 + h * 192; float sk = 0.f;
#pragma unroll
        for (int v = 0; v < 4; ++v) { float f[8]; unpack8(*(const u32x4*)(kp + 8 * v), f);
#pragma unroll
            for (int e = 0; e < 8; ++e) { x[8 * v + e] = f[e]; sk += f[e] * f[e]; } }
        sk = quad_sum(sk); const float rk = frsq(sk * (1.f / 128.f) + EPS);
#pragma unroll
        for (int v = 0; v < 4; ++v) { float f[8];
#pragma unroll
            for (int e = 0; e < 8; ++e) f[e] = x[8 * v + e] * rk * gkn[8 * v + e];
            *(u32x4*)(kn + 32 * s + 8 * v) = pack8(f); }
        const u32x4 k0 = *(const u32x4*)(KR + (size_t)m * 64 + 16 * s), k1 = *(const u32x4*)(KR + (size_t)m * 64 + 16 * s + 8);
        *(u32x4*)(kn + 128 + 16 * s) = k0; *(u32x4*)(kn + 128 + 16 * s + 8) = k1;
    }
}
__device__ __forceinline__ void swa_norm_rope(bf16* p, const float (&g)[32], bool isl, int t, int s, const float* tab, bool store) {
    float x[32]; float ss = 0.f;
#pragma unroll
    for (int v = 0; v < 4; ++v) { float f[8]; unpack8(*(const u32x4*)(p + 8 * v), f);
#pragma unroll
        for (int e = 0; e < 8; ++e) { x[8 * v + e] = f[e]; ss += f[e] * f[e]; } }
    const int pos = (s < 2) ? (t >> 6) : (t & 63); const float* tc = tab + ((s < 2) ? T_SC_R : T_SC_C) + pos * 32; const float* ts = tab + ((s < 2) ? T_SS_R : T_SS_C) + pos * 32;
    f32x4 cv[8], sv[8];
#pragma unroll
    for (int v = 0; v < 8; ++v) { cv[v] = ((const f32x4*)tc)[v]; sv[v] = ((const f32x4*)ts)[v]; }
    ss = quad_sum(ss); const float rn = frsq(ss * (1.f / 128.f) + EPS);
#pragma unroll
    for (int v = 0; v < 4; ++v) { float f[8];
#pragma unroll
        for (int e = 0; e < 8; ++e) { const int j = 8 * v + e; float y = x[j] * rn * g[j]; const float py = __shfl_xor(y, 1);
            const float cs = isl ? cv[j >> 2][j & 3] : 1.f, sn = isl ? sv[j >> 2][j & 3] : 0.f;
            y = (s & 1) ? py * sn + y * cs : y * cs - py * sn;
            f[e] = y; }
        if (store) *(u32x4*)(p + 8 * v) = pack8(f); }
}
__device__ __forceinline__ void swa_prep(bf16* QKV, const float* qkg, const float* tab, const float* part, int gw, int NGW, int lane) {
    const int h = (lane >> 2) & 3, s = lane & 3;
    float gk[32];
#pragma unroll
    for (int i = 0; i < 32; ++i) gk[i] = qkg[128 + 32 * s + i];
    for (int m = 4 * gw + (lane >> 4); m < MLAT; m += 4 * NGW) {
        const int t = m & (SEQ - 1);
        swa_norm_rope(QKV + (size_t)m * 3072 + 2048 + h * 128 + 32 * s, gk, true, t, s, tab, true);
    }
    for (int r = gw; r < MCTX; r += NGW) {
        f32x4 a[4] = {{0.f, 0.f, 0.f, 0.f}, {0.f, 0.f, 0.f, 0.f}, {0.f, 0.f, 0.f, 0.f}, {0.f, 0.f, 0.f, 0.f}};
#pragma unroll
        for (int q = 0; q < 8; ++q) { const float* pp = part + ((size_t)q * 512 + r) * 1024 + 16 * lane;
#pragma unroll
            for (int v = 0; v < 4; ++v) a[v] += *(const f32x4*)(pp + 4 * v); }
        float ss = 0.f;
#pragma unroll
        for (int v = 0; v < 4; ++v) ss += (a[v].x * a[v].x + a[v].y * a[v].y) + (a[v].z * a[v].z + a[v].w * a[v].w);
        ss += __shfl_xor(ss, 1); ss += __shfl_xor(ss, 2); ss += __shfl_xor(ss, 4);
        const float rn = lane < 32 ? frsq(ss * (1.f / 128.f) + EPS) : 1.f;
        float f0[8], f1[8];
#pragma unroll
        for (int e = 0; e < 8; ++e) { const int c = e, c2 = 8 + e; const float g0 = lane < 32 ? qkg[128 + 16 * (lane & 7) + c] : 1.f, g1 = lane < 32 ? qkg[128 + 16 * (lane & 7) + c2] : 1.f;
            f0[e] = a[c >> 2][c & 3] * rn * g0; f1[e] = a[c2 >> 2][c2 & 3] * rn * g1; }
        bf16* dst = QKV + (size_t)(MLAT + r) * 3072 + 2048 + 16 * lane;
        *(u32x4*)dst = pack8(f0); *(u32x4*)(dst + 8) = pack8(f1);
    }
}
__device__ __forceinline__ void gla_final(const bf16* OF, const bf16* OB, const bf16* Gs, const float* gn, bf16* Y, int gw, int NGW, int lane) {
    const int h = lane >> 2, s = lane & 3;
    float gng[32];
#pragma unroll
    for (int i = 0; i < 32; ++i) gng[i] = gn[32 * s + i];
    for (int m = gw; m < MROWS; m += NGW) {
        const size_t off = (size_t)m * DM + h * 128 + 32 * s; float x[32]; float ss = 0.f;
#pragma unroll
        for (int v = 0; v < 4; ++v) { float a[8], b[8]; unpack8(*(const u32x4*)(OF + off + 8 * v), a); unpack8(*(const u32x4*)(OB + off + 8 * v), b);
#pragma unroll
            for (int e = 0; e < 8; ++e) { const float o = a[e] + b[e]; x[8 * v + e] = o; ss += o * o; } }
        ss = quad_sum(ss); const float rn = frsq(ss * (1.f / 128.f) + EPS);
#pragma unroll
        for (int v = 0; v < 4; ++v) { float gg[8], f[8]; unpack8(*(const u32x4*)(Gs + off + 8 * v), gg);
#pragma unroll
            for (int e = 0; e < 8; ++e) f[e] = x[8 * v + e] * rn * gng[8 * v + e] * silu(gg[e]);
            *(u32x4*)(Y + off + 8 * v) = pack8(f); }
    }
}
#define XB_TMO      128
#define XB_XCNT(j)  (256  + 64 * (j))
#define XB_XSUB(j)  (1280 + 64 * (j))
#define XB_XGEN(j)  (2304 + 64 * (j))
#define XB_TOP      3328
#define XB_TOPGEN   3392
#define XCD_BAR_WORDS 3456
#define XB_SPIN_CAP (1u << 18)

__device__ __forceinline__ unsigned xb_ld(unsigned* p)              { return __hip_atomic_load(p, __ATOMIC_RELAXED, __HIP_MEMORY_SCOPE_AGENT); }
__device__ __forceinline__ unsigned xb_add(unsigned* p, unsigned v) { return __hip_atomic_fetch_add(p, v, __ATOMIC_RELAXED, __HIP_MEMORY_SCOPE_AGENT); }
__device__ __forceinline__ unsigned xb_xcc_id() { return (unsigned)__builtin_amdgcn_s_getreg((3 << 11) | 20) & 0xFu; }
#define XB_SPIN(cond, bar) do { unsigned _sp = 0; while (cond) { __builtin_amdgcn_s_sleep(1); \
    if ((++_sp & 255u) == 0u) { if (xb_ld(&(bar)[XB_TMO])) break; if (_sp > XB_SPIN_CAP) { atomicAdd(&(bar)[XB_TMO], 1u); break; } } } } while (0)

struct XcdBarrier {
    unsigned* bar; unsigned x;
    volatile LAS unsigned* st;
};

__device__ __forceinline__ XcdBarrier xcd_barrier_post(unsigned* bar, volatile LAS unsigned* st) {
    XcdBarrier b; b.bar = bar; b.x = xb_xcc_id(); b.st = st;
    if (threadIdx.x == 0) (void)xb_add(&bar[XB_XCNT(b.x)], 1u);
    return b;
}
__device__ __forceinline__ void xcd_barrier_complete(unsigned* bar, unsigned x, unsigned& nloc, unsigned& nx) {
    const unsigned G = gridDim.x * gridDim.y * gridDim.z;
    unsigned sum, cnt, mine, sp = 0u;
    for (;;) {
        sum = 0u; cnt = 0u; mine = 0u;
#pragma unroll
        for (unsigned j = 0; j < 16; ++j) { const unsigned c = xb_ld(&bar[XB_XCNT(j)]); sum += c; cnt += (c > 0u) ? 1u : 0u; mine = (j == x) ? c : mine; }
        if (sum == G) break;
        __builtin_amdgcn_s_sleep(1);
        if ((++sp & 255u) == 0u) { if (xb_ld(&bar[XB_TMO])) break; if (sp > XB_SPIN_CAP) { atomicAdd(&bar[XB_TMO], 1u); break; } }
    }
    nloc = mine > 0u ? mine : 1u; nx = cnt > 0u ? cnt : 1u;
}

__device__ __forceinline__ void xcd_barrier(const XcdBarrier& b) {
    asm volatile("s_waitcnt vmcnt(0)" ::: "memory");
    __syncthreads();
    if (threadIdx.x == 0) {
        unsigned* bar = b.bar;
        __builtin_amdgcn_s_waitcnt(0);
        unsigned nloc = b.st[0], nx = b.st[1];
        if (nloc == 0u) { xcd_barrier_complete(bar, b.x, nloc, nx); b.st[0] = nloc; b.st[1] = nx; }
        const unsigned old = xb_add(&bar[XB_XSUB(b.x)], 1u);
        const unsigned gen = old / nloc;
        if (old + 1u == (gen + 1u) * nloc) {
            __builtin_amdgcn_fence(__ATOMIC_RELEASE, "agent");
            asm volatile("s_waitcnt vmcnt(0)" ::: "memory");
            const unsigned og = xb_add(&bar[XB_TOP], 1u);
            const unsigned tg = og / nx;
            if (og + 1u == (tg + 1u) * nx) xb_add(&bar[XB_TOPGEN], 1u);
            else XB_SPIN(xb_ld(&bar[XB_TOPGEN]) == tg, bar);
            __builtin_amdgcn_fence(__ATOMIC_ACQUIRE, "agent");
            xb_add(&bar[XB_XGEN(b.x)], 1u);
            asm volatile("s_waitcnt vmcnt(0)" ::: "memory");
        } else {
            XB_SPIN(xb_ld(&bar[XB_XGEN(b.x)]) == gen, bar);
            __builtin_amdgcn_fence(__ATOMIC_ACQUIRE, "agent");
            asm volatile("s_waitcnt vmcnt(0)" ::: "memory");
        }
    }
    __syncthreads();
}
__device__ __forceinline__ f32x4 mm16(const LAS unsigned char* A, int lda, const LAS unsigned char* Bt, int ldb, int ksteps, f32x4 acc, int l15, int quad) {
    const LAS unsigned char* ap = A + l15 * lda + quad * 16; const LAS unsigned char* bp = Bt + l15 * ldb + quad * 16;
    for (int kk = 0; kk < ksteps; ++kk) {
        const bf16x8 a = *(const LAS bf16x8*)(ap + kk * 64), b = *(const LAS bf16x8*)(bp + kk * 64);
        acc = __builtin_amdgcn_mfma_f32_16x16x32_bf16(a, b, acc, 0, 0, 0);
    }
    return acc;
}

#define LDS_BARRIER() do { asm volatile("s_waitcnt lgkmcnt(0)" ::: "memory"); __builtin_amdgcn_s_barrier(); asm volatile("" ::: "memory"); } while (0)
struct AB { float a, b; };
__device__ __forceinline__ AB comb(AB e1, AB e2) { AB r; r.a = e1.a * e2.a; r.b = e2.a * e1.b + e2.b; return r; }
__device__ __forceinline__ AB shfl_ab_up(AB v, int d) { AB r; r.a = __shfl_up(v.a, d); r.b = __shfl_up(v.b, d); return r; }
__device__ __forceinline__ AB shfl_ab_dn(AB v, int d) { AB r; r.a = __shfl_down(v.a, d); r.b = __shfl_down(v.b, d); return r; }
__device__ __forceinline__ AB shfl_ab(AB v, int l) { AB r; r.a = __shfl(v.a, l); r.b = __shfl(v.b, l); return r; }
constexpr int RG_U32 = 0, RG_UBF = 33792, RG_OSUM = RG_UBF + 17408, RG_CW = RG_OSUM + 33792, RG_END = RG_CW + 2560;
template <int PASS> __device__ __forceinline__ void rglru_items(const bf16* GR, const float* convw, const float* convb, const bf16* WG, const float* gateb, const float* lam,
                                                                float* CARRY, const float* HIN, bf16* Y, LAS unsigned char* lds, int bid, int G, int tid) {
    const int lane = tid & 63, w = tid >> 6, l15 = lane & 15, quad = lane >> 4;
    LAS float* U32 = (LAS float*)(lds + RG_U32); LAS unsigned char* UBF = lds + RG_UBF; LAS float* OSUM = (LAS float*)(lds + RG_OSUM);
    int kcur = -1; float sp[2], gb[2][2]; bf16x8 bfr[2][2][4]; LAS float* CW = (LAS float*)(lds + RG_CW);
    u32x4 pre[4][2]; bool pre_ok[4];
    const int tt = tid >> 3, cg = tid & 7;
#define RG_SEQ(r0_, s0_, s1_) do { if ((r0_) < MLAT) { s0_ = (r0_) & ~(SEQ - 1); s1_ = s0_ + SEQ; } else { s0_ = MLAT + (((r0_) - MLAT) & ~(CTXL - 1)); s1_ = s0_ + CTXL; } } while (0)
#define RG_PREFETCH(item_) do { const int k_ = (item_) & 15, r0_ = ((item_) >> 4) * 64; int s0_, s1_; RG_SEQ(r0_, s0_, s1_); const int c0_ = k_ * 128 + cg * 16; \
        _Pragma("unroll") for (int j = 0; j < 4; ++j) { const int rr = r0_ + tt + j - 2; pre_ok[j] = rr >= s0_ && rr < s1_; \
            if (pre_ok[j]) { pre[j][0] = *(const u32x4*)(GR + (size_t)rr * 4096 + 2048 + c0_); pre[j][1] = *(const u32x4*)(GR + (size_t)rr * 4096 + 2048 + c0_ + 8); } } } while (0)
    if (bid < 520 * 16) RG_PREFETCH(bid);
    for (int item = bid; item < 520 * 16; item += G) {
        const int k = item & 15, ch = item >> 4, r0 = ch * 64;
        const int c = k * 128 + 16 * w + l15;
        if (k != kcur) { kcur = k;
#pragma unroll
            for (int d = 0; d < 2; ++d)
#pragma unroll
                for (int g = 0; g < 2; ++g)
#pragma unroll
                    for (int kk = 0; kk < 4; ++kk) bfr[d][g][kk] = *(const bf16x8*)(WG + ((size_t)k * 512 + (d * 2 + g) * 128 + 16 * w + l15) * 128 + kk * 32 + quad * 8);
            LDS_BARRIER();
            for (int i = tid; i < 5 * 128; i += NTHR) { const int j = i >> 7, cc_ = i & 127; CW[i] = j < 4 ? convw[j * 2048 + k * 128 + cc_] : convb[k * 128 + cc_]; }
            LDS_BARRIER();
        }
        {
            float acc[16];
#pragma unroll
            for (int v = 0; v < 4; ++v) { const f32x4 b4 = *(const LAS f32x4*)(CW + 4 * 128 + cg * 16 + 4 * v); acc[4 * v] = b4.x; acc[4 * v + 1] = b4.y; acc[4 * v + 2] = b4.z; acc[4 * v + 3] = b4.w; }
#pragma unroll
            for (int j = 0; j < 4; ++j) { if (pre_ok[j]) { float x0[8], x1[8]; unpack8(pre[j][0], x0); unpack8(pre[j][1], x1);
#pragma unroll
                    for (int v = 0; v < 2; ++v) { const f32x4 wa = *(const LAS f32x4*)(CW + j * 128 + cg * 16 + 4 * v), wb = *(const LAS f32x4*)(CW + j * 128 + cg * 16 + 8 + 4 * v);
                        acc[4 * v] += wa.x * x0[4 * v]; acc[4 * v + 1] += wa.y * x0[4 * v + 1]; acc[4 * v + 2] += wa.z * x0[4 * v + 2]; acc[4 * v + 3] += wa.w * x0[4 * v + 3];
                        acc[8 + 4 * v] += wb.x * x1[4 * v]; acc[8 + 4 * v + 1] += wb.y * x1[4 * v + 1]; acc[8 + 4 * v + 2] += wb.z * x1[4 * v + 2]; acc[8 + 4 * v + 3] += wb.w * x1[4 * v + 3]; } } }
#pragma unroll
            for (int v = 0; v < 4; ++v) *(LAS f32x4*)(U32 + tt * 132 + cg * 16 + 4 * v) = (f32x4){acc[4 * v], acc[4 * v + 1], acc[4 * v + 2], acc[4 * v + 3]};
            float f0[8], f1[8];
#pragma unroll
            for (int e = 0; e < 8; ++e) { f0[e] = acc[e]; f1[e] = acc[8 + e]; }
            *(LAS u32x4*)(UBF + tt * 272 + cg * 32) = pack8(f0); *(LAS u32x4*)(UBF + tt * 272 + cg * 32 + 16) = pack8(f1);
        }
        if (item + G < 520 * 16) RG_PREFETCH(item + G);
        LDS_BARRIER();
#pragma unroll
        for (int d = 0; d < 2; ++d) { const float y = fexp(-lam[d * 2048 + c]); sp[d] = (y < 0.03f) ? y * (1.f - y * (0.5f - y * (0.33333334f - 0.25f * y))) : flog(1.f + y);
            gb[d][0] = gateb[(d * 2 + 0) * 2048 + c]; gb[d][1] = gateb[(d * 2 + 1) * 2048 + c]; }
        float Aa[2][4][4], Bx[2][4][4];
#pragma unroll
        for (int rb = 0; rb < 4; ++rb) {
            f32x4 ac[2][2] = {{{0.f, 0.f, 0.f, 0.f}, {0.f, 0.f, 0.f, 0.f}}, {{0.f, 0.f, 0.f, 0.f}, {0.f, 0.f, 0.f, 0.f}}};
#pragma unroll
            for (int kk = 0; kk < 4; ++kk) { const bf16x8 a = *(const LAS bf16x8*)(UBF + (rb * 16 + l15) * 272 + kk * 64 + quad * 16);
#pragma unroll
                for (int d = 0; d < 2; ++d)
#pragma unroll
                    for (int g = 0; g < 2; ++g) ac[d][g] = __builtin_amdgcn_mfma_f32_16x16x32_bf16(a, bfr[d][g][kk], ac[d][g], 0, 0, 0); }
#pragma unroll
            for (int i = 0; i < 4; ++i) { const float uv = U32[(rb * 16 + quad * 4 + i) * 132 + 16 * w + l15];
#pragma unroll
                for (int d = 0; d < 2; ++d) { const float rg = sigm(ac[d][0][i] + gb[d][0]), ig = sigm(ac[d][1][i] + gb[d][1]);
                    const float la = -8.f * rg * sp[d], z = 2.f * la, av = fexp(la); const float om = (z > -0.01f) ? -z * (1.f + z * (0.5f + z * 0.16666667f)) : 1.f - av * av;
                    Aa[d][rb][i] = av; Bx[d][rb][i] = __builtin_amdgcn_sqrtf(om) * ig * uv; } }
        }
        u32x4 gq0, gq1;
        if (PASS == 2) { gq0 = *(const u32x4*)(GR + (size_t)(r0 + tt) * 4096 + k * 128 + cg * 16); gq1 = *(const u32x4*)(GR + (size_t)(r0 + tt) * 4096 + k * 128 + cg * 16 + 8); }
        float hs[4][4];
#pragma unroll
        for (int rb = 0; rb < 4; ++rb)
#pragma unroll
            for (int i = 0; i < 4; ++i) hs[rb][i] = 0.f;
#pragma unroll
        for (int d = 0; d < 2; ++d) {
            AB tot; tot.a = 1.f; tot.b = 0.f; float Hc = 0.f;
            if (PASS == 2) Hc = HIN[((size_t)ch * 2 + d) * 2048 + c];
#pragma unroll
            for (int rbi = 0; rbi < 4; ++rbi) { const int rb = d == 0 ? rbi : 3 - rbi;
                AB seg; seg.a = 1.f; seg.b = 0.f;
#pragma unroll
                for (int ii = 0; ii < 4; ++ii) { const int i = d == 0 ? ii : 3 - ii; seg.b = Aa[d][rb][i] * seg.b + Bx[d][rb][i]; seg.a = seg.a * Aa[d][rb][i]; }
                AB inc = seg, t, rbt, ex;
                if (d == 0) { t = shfl_ab_up(inc, 16); if (quad >= 1) inc = comb(t, inc); t = shfl_ab_up(inc, 32); if (quad >= 2) inc = comb(t, inc); rbt = shfl_ab(inc, 48 + l15);
                              ex = shfl_ab_up(inc, 16); if (quad == 0) { ex.a = 1.f; ex.b = 0.f; } }
                else        { t = shfl_ab_dn(inc, 16); if (quad <= 2) inc = comb(t, inc); t = shfl_ab_dn(inc, 32); if (quad <= 1) inc = comb(t, inc); rbt = shfl_ab(inc, l15);
                              ex = shfl_ab_dn(inc, 16); if (quad == 3) { ex.a = 1.f; ex.b = 0.f; } }
                if (PASS == 1) tot = comb(tot, rbt);
                else { float s = ex.a * Hc + ex.b;
#pragma unroll
                    for (int ii = 0; ii < 4; ++ii) { const int i = d == 0 ? ii : 3 - ii; s = Aa[d][rb][i] * s + Bx[d][rb][i]; hs[rb][i] += s; }
                    Hc = rbt.a * Hc + rbt.b; }
            }
            if (PASS == 1 && quad == 0) { CARRY[(((size_t)ch * 2 + d) * 2 + 0) * 2048 + c] = tot.a; CARRY[(((size_t)ch * 2 + d) * 2 + 1) * 2048 + c] = tot.b; }
        }
        if (PASS == 2) {
#pragma unroll
            for (int rb = 0; rb < 4; ++rb)
#pragma unroll
                for (int i = 0; i < 4; ++i) OSUM[(rb * 16 + quad * 4 + i) * 132 + 16 * w + l15] = hs[rb][i];
            LDS_BARRIER();
            const int r = r0 + tt, c0 = k * 128 + cg * 16;
            float g0[8], g1[8], o0[8], o1[8]; unpack8(gq0, g0); unpack8(gq1, g1);
#pragma unroll
            for (int e = 0; e < 8; ++e) { const float x = g0[e], x2 = g1[e];
                o0[e] = x * sigm(1.5957691216f * (x + 0.044715f * x * x * x)) * OSUM[tt * 132 + cg * 16 + e];
                o1[e] = x2 * sigm(1.5957691216f * (x2 + 0.044715f * x2 * x2 * x2)) * OSUM[tt * 132 + cg * 16 + 8 + e]; }
            *(u32x4*)(Y + (size_t)r * DM + c0) = pack8(o0); *(u32x4*)(Y + (size_t)r * DM + c0 + 8) = pack8(o1);
        }
        LDS_BARRIER();
    }
}
__device__ __forceinline__ void rglru_prop(const float* __restrict__ CARRY, float* __restrict__ HIN, LAS float* sm, int bid, int G, int tid) {
    const int cl = tid & 31, seg = tid >> 5;
    for (int grp = bid; grp < 256; grp += G) {
        const int c = (grp & 63) * 32 + cl, d = (grp >> 6) & 1, b = grp >> 7;
        float a[20], bb[20]; int chs[20]; float A = 1.f, B = 0.f;
        if (seg < 13) {
#pragma unroll
            for (int k = 0; k < 20; ++k) { const int step = seg * 20 + k;
                int ch; if (d == 0) ch = step < 4 ? (512 + 4 * b + step) : (256 * b + step - 4); else ch = step < 4 ? (512 + 4 * b + 3 - step) : (256 * b + 255 - (step - 4));
                chs[k] = ch; a[k] = CARRY[(((size_t)ch * 2 + d) * 2 + 0) * 2048 + c]; bb[k] = CARRY[(((size_t)ch * 2 + d) * 2 + 1) * 2048 + c]; }
#pragma unroll
            for (int k = 0; k < 20; ++k) { B = a[k] * B + bb[k]; A = a[k] * A; }
            sm[(seg * 32 + cl) * 2] = A; sm[(seg * 32 + cl) * 2 + 1] = B;
        }
        __syncthreads();
        if (seg < 13) { float H = 0.f;
            for (int q = 0; q < seg; ++q) H = sm[(q * 32 + cl) * 2] * H + sm[(q * 32 + cl) * 2 + 1];
#pragma unroll
            for (int k = 0; k < 20; ++k) { HIN[((size_t)chs[k] * 2 + d) * 2048 + c] = H; H = a[k] * H + bb[k]; } }
        __syncthreads();
    }
}

constexpr int GL_QT = 0, GL_KT = 17408, GL_QS = 34816, GL_KST = 52224, GL_VT = 70656, GL_ST = 89088, GL_PP = 123904, GL_SEGT = 133120, GL_DVEC = 135168, GL_END = 135680;
static_assert(GL_END <= RING_BYTES && RG_END <= RING_BYTES, "LDS");
template <int PASS> __device__ __forceinline__ void gla_items(const bf16* HG, const float* lbv, float* ST, float* DVG, bf16* OFb, bf16* OBb, LAS unsigned char* lds, int bid, int G, int tid) {
    const int lane = tid & 63, w = tid >> 6, l15 = lane & 15, quad = lane >> 4;
    const int dk = tid & 127, seg = tid >> 7;
    LAS float* SEGT = (LAS float*)(lds + GL_SEGT); LAS float* DVEC = (LAS float*)(lds + GL_DVEC);
    const size_t SECE = (size_t)MROWS * DM;
    u32x4 rz[2], rv[2], rq[2];
#define GL_DECODE(item_, sc_, h_, d_, b_, R0_) const int sc_ = (item_) % 65, h_ = ((item_) / 65) & 15, d_ = ((item_) / 1040) & 1, b_ = (item_) / 2080; \
        const int R0_ = sc_ == 0 ? MLAT + CTXL * b_ : SEQ * b_ + 256 * (d_ == 0 ? sc_ - 1 : 64 - sc_)
#define GL_FETCH(item_, cc_) do { GL_DECODE(item_, fsc_, fh_, fd_, fb_, fR0_); (void)fsc_; (void)fb_; \
        _Pragma("unroll") for (int hf = 0; hf < 2; ++hf) { const int p = (tid >> 4) + 32 * hf; const int tok = fd_ == 0 ? fR0_ + 64 * (cc_) + p : fR0_ + 255 - 64 * (cc_) - p; \
            const bf16* rowp = HG + (size_t)tok * DM + fh_ * 128 + (tid & 15) * 8; \
            rz[hf] = *(const u32x4*)(rowp + (size_t)(1 + fd_) * SECE); rv[hf] = *(const u32x4*)(rowp + 3 * SECE); if (PASS == 2) rq[hf] = *(const u32x4*)rowp; } } while (0)
    unsigned tch = 0u;
#define GL_TOUCH(item_, cc_) do { if (tid < (PASS == 2 ? 384 : 256)) { GL_DECODE(item_, tsc_, th_, td_, tb_, tR0_); (void)tsc_; (void)tb_; const int p = tid & 63, hl = (tid >> 6) & 1, sec = tid >> 7; \
            const int tok = td_ == 0 ? tR0_ + 64 * (cc_) + p : tR0_ + 255 - 64 * (cc_) - p; \
            tch = *(const unsigned*)(HG + (size_t)tok * DM + th_ * 128 + hl * 64 + (size_t)(sec == 0 ? 1 + td_ : sec == 1 ? 3 : 0) * SECE); } } while (0)
    if (bid < 4160) { GL_FETCH(bid, 0); GL_TOUCH(bid, 1); }
    for (int item = bid; item < 4160; item += G) {
        GL_DECODE(item, sc, h, d, b, R0); (void)sc; (void)b;
        const float lb = lbv[d * 2048 + h * 128 + dk], oml = 1.f - lb;
        bf16* OD = d == 0 ? OFb : OBb;
        f32x4 sacc[8];
#pragma unroll
        for (int j = 0; j < 8; ++j) sacc[j] = (f32x4){0.f, 0.f, 0.f, 0.f};
        if (PASS == 2) {
            const float* sp = ST + (size_t)item * 16384;
#pragma unroll
            for (int j = 0; j < 8; ++j)
#pragma unroll
                for (int i = 0; i < 4; ++i) { const float v = sp[(16 * w + quad * 4 + i) * 128 + 16 * j + l15]; sacc[j][i] = v;
                    *(LAS unsigned short*)(lds + GL_ST + (16 * w + quad * 4 + i) * 272 + (16 * j + l15) * 2) = f2bf(v); }
        }
        float ctotal = 0.f;
        for (int cc = 0; cc < 4; ++cc) {
#pragma unroll
            for (int hf = 0; hf < 2; ++hf) { const int p = (tid >> 4) + 32 * hf, c16 = tid & 15;
                *(LAS u32x4*)(lds + GL_KT + p * 272 + c16 * 16) = rz[hf]; *(LAS u32x4*)(lds + GL_QS + p * 272 + c16 * 16) = rv[hf];
                if (PASS == 2) *(LAS u32x4*)(lds + GL_QT + p * 272 + c16 * 16) = rq[hf]; }
            LDS_BARRIER();
            asm volatile("" :: "v"(tch));
            if (cc < 3) GL_FETCH(item, cc + 1); else if (item + G < 4160) GL_FETCH(item + G, 0);
            if (cc < 2) GL_TOUCH(item, cc + 2); else if (item + G < 4160) GL_TOUCH(item + G, cc - 2);
            float lc[16], kv[16], vv[16], qq[16]; float run = 0.f;
#pragma unroll
            for (int i = 0; i < 16; ++i) { const int p = 16 * seg + i;
                const float z = bf2f(*(const LAS unsigned short*)(lds + GL_KT + p * 272 + dk * 2)); vv[i] = bf2f(*(const LAS unsigned short*)(lds + GL_QS + p * 272 + dk * 2));
                if (PASS == 2) qq[i] = silu(bf2f(*(const LAS unsigned short*)(lds + GL_QT + p * 272 + dk * 2)));
                const float e = fexp(-z), inv = frcp(1.f + e); kv[i] = oml * e * inv; const float f = lb + oml * inv; run += flog(f); lc[i] = run; }
            SEGT[seg * 128 + dk] = run;
            LDS_BARRIER();
            const float t0 = SEGT[dk], t1 = SEGT[128 + dk], t2 = SEGT[256 + dk], t3 = SEGT[384 + dk];
            const float off = seg == 0 ? 0.f : seg == 1 ? t0 : seg == 2 ? t0 + t1 : t0 + t1 + t2; const float cref = t0 + t1, clast = (t0 + t1) + (t2 + t3);
            ctotal += clast;
            float ks[16];
            const float ecr = fexp(cref), ecl = fexp(clast - cref);
#pragma unroll
            for (int i = 0; i < 16; ++i) { const int p = 16 * seg + i; const float cum = off + lc[i];
                if (PASS == 2) { const float e1 = fexp(cum - cref), e2 = fexp(cref - cum), qe = qq[i] * e1, ke = kv[i] * e2; ks[i] = ke * ecl;
                    *(LAS unsigned short*)(lds + GL_QT + p * 272 + dk * 2) = f2bf(qe);
                    *(LAS unsigned short*)(lds + GL_KT + p * 272 + dk * 2) = f2bf(ke);
                    *(LAS unsigned short*)(lds + GL_QS + p * 272 + dk * 2) = f2bf(qe * ecr); }
                else ks[i] = kv[i] * fexp(clast - cum); }
            { float f0[8], f1[8];
#pragma unroll
              for (int e = 0; e < 8; ++e) { f0[e] = ks[e]; f1[e] = ks[8 + e]; }
              *(LAS u32x4*)(lds + GL_KST + dk * 144 + seg * 32) = pack8(f0); *(LAS u32x4*)(lds + GL_KST + dk * 144 + seg * 32 + 16) = pack8(f1);
#pragma unroll
              for (int e = 0; e < 8; ++e) { f0[e] = vv[e]; f1[e] = vv[8 + e]; }
              *(LAS u32x4*)(lds + GL_VT + dk * 144 + seg * 32) = pack8(f0); *(LAS u32x4*)(lds + GL_VT + dk * 144 + seg * 32 + 16) = pack8(f1); }
            if (seg == 0) DVEC[dk] = fexp(clast);
            LDS_BARRIER();
            if (PASS == 2) {
                const int pb = w >> 1;
#pragma unroll
                for (int sbl = 0; sbl < 2; ++sbl) { const int sb = 2 * (w & 1) + sbl; f32x4 a4 = {0.f, 0.f, 0.f, 0.f};
                    if (sb <= pb) a4 = mm16(lds + GL_QT + pb * 16 * 272, 272, lds + GL_KT + sb * 16 * 272, 272, 4, a4, l15, quad);
#pragma unroll
                    for (int i = 0; i < 4; ++i) { const int p = pb * 16 + quad * 4 + i, s = sb * 16 + l15; const float v = (sb <= pb && s <= p) ? a4[i] : 0.f;
                        *(LAS unsigned short*)(lds + GL_PP + p * 144 + s * 2) = f2bf(v); } }
                LDS_BARRIER();
#pragma unroll
                for (int dvl = 0; dvl < 4; ++dvl) { const int dvb = 4 * (w & 1) + dvl; f32x4 o4 = {0.f, 0.f, 0.f, 0.f};
                    o4 = mm16(lds + GL_PP + pb * 16 * 144, 144, lds + GL_VT + dvb * 16 * 144, 144, 2, o4, l15, quad);
                    o4 = mm16(lds + GL_QS + pb * 16 * 272, 272, lds + GL_ST + dvb * 16 * 272, 272, 4, o4, l15, quad);
#pragma unroll
                    for (int i = 0; i < 4; ++i) { const int p = pb * 16 + quad * 4 + i; const int tok = d == 0 ? R0 + 64 * cc + p : R0 + 255 - 64 * cc - p;
                        OD[(size_t)tok * DM + h * 128 + dvb * 16 + l15] = f2bf(o4[i]); } }
            }
#pragma unroll
            for (int j = 0; j < 8; ++j) { const float dd = DVEC[16 * j + l15]; sacc[j] = sacc[j] * dd;
                sacc[j] = mm16(lds + GL_VT + w * 16 * 144, 144, lds + GL_KST + j * 16 * 144, 144, 2, sacc[j], l15, quad); }
            if (PASS == 2) {
                LDS_BARRIER();
#pragma unroll
                for (int j = 0; j < 8; ++j)
#pragma unroll
                    for (int i = 0; i < 4; ++i) *(LAS unsigned short*)(lds + GL_ST + (16 * w + quad * 4 + i) * 272 + (16 * j + l15) * 2) = f2bf(sacc[j][i]);
            }
            LDS_BARRIER();
        }
        if (PASS == 1) {
            float* sp = ST + (size_t)item * 16384;
#pragma unroll
            for (int j = 0; j < 8; ++j)
#pragma unroll
                for (int i = 0; i < 4; ++i) sp[(16 * w + quad * 4 + i) * 128 + 16 * j + l15] = sacc[j][i];
            if (seg == 0) DVG[(size_t)item * 128 + dk] = fexp(ctotal);
        }
    }
}
__device__ __forceinline__ void gla_prop(float* ST, const float* __restrict__ DVG, int gt, int NGT) {
    for (int id = gt; id < 64 * 4096; id += NGT) {
        const int bdh = id >> 12, e = (id & 4095) * 4; f32x4 S = {0.f, 0.f, 0.f, 0.f};
        for (int s0 = 0; s0 < 65; s0 += 13) { f32x4 t[13], dd[13];
#pragma unroll
            for (int k = 0; k < 13; ++k) { const size_t idx = (size_t)bdh * 65 + s0 + k; t[k] = *(const f32x4*)(ST + idx * 16384 + e); dd[k] = *(const f32x4*)(DVG + idx * 128 + (e & 127)); }
#pragma unroll
            for (int k = 0; k < 13; ++k) { const size_t idx = (size_t)bdh * 65 + s0 + k; *(f32x4*)(ST + idx * 16384 + e) = S; S = dd[k] * S + t[k]; } }
    }
}
namespace att {
using s16x4  = __attribute__((ext_vector_type(4))) short;
using f32x16 = __attribute__((ext_vector_type(16))) float;
constexpr int NW = 8, QBLK = 32, KVBLK = 64;
#define ATT_SBAR() __builtin_amdgcn_sched_barrier(0)
__device__ __forceinline__ int crow(int r, int hi) { return (r & 3) + 8 * (r >> 2) + 4 * hi; }
__device__ __forceinline__ unsigned cvtpk(float lo, float hi) { unsigned r; asm volatile("v_cvt_pk_bf16_f32 %0, %1, %2" : "=v"(r) : "v"(lo), "v"(hi)); return r; }
__device__ __forceinline__ void partialSM(f32x16& p0, f32x16& p1, float& m_reg, float& mn, float& alpha, const float C, const float thr, const float fixref = 0.f) {
  float mnC;
  if (fixref > 0.f) {
    mn = m_reg; alpha = 1.f;
#pragma unroll
    for (int r = 0; r < 16; ++r) p0[r] = __builtin_amdgcn_exp2f(p0[r]);
    return;
  }
  {
  float pmax = p0[0];
#pragma unroll
  for (int r = 1; r < 16; ++r) pmax = fmaxf(pmax, p0[r]);
#pragma unroll
  for (int r = 0; r < 16; ++r) pmax = fmaxf(pmax, p1[r]);
  { auto rr = __builtin_amdgcn_permlane32_swap(__float_as_uint(pmax), __float_as_uint(pmax), false, false);
    pmax = fmaxf(__uint_as_float(rr[0]), __uint_as_float(rr[1])); }
  if (__builtin_expect(__all(pmax - m_reg <= thr), 1)) { mn = m_reg; alpha = 1.f; }
  else { mn = fmaxf(m_reg, pmax); alpha = __builtin_amdgcn_exp2f((m_reg - mn) * C); m_reg = mn; }
  mnC = -mn * C;
  }
#pragma unroll
  for (int r = 0; r < 16; ++r) p0[r] = fmaf(p0[r], C, mnC);
#pragma unroll
  for (int r = 0; r < 16; ++r) p1[r] = fmaf(p1[r], C, mnC);
#pragma unroll
  for (int r = 0; r < 16; ++r) p0[r] = __builtin_amdgcn_exp2f(p0[r]);
}
__device__ __forceinline__ void finishSM(f32x16& p0, f32x16& p1, float alpha, float& l_reg, bf16x8& pa0, bf16x8& pa1, bf16x8& pa2, bf16x8& pa3) {
#pragma unroll
  for (int r = 0; r < 16; ++r) p1[r] = __builtin_amdgcn_exp2f(p1[r]);
  float ps = 0;
#pragma unroll
  for (int r = 0; r < 16; ++r) ps += p0[r];
#pragma unroll
  for (int r = 0; r < 16; ++r) ps += p1[r];
  { auto rr = __builtin_amdgcn_permlane32_swap(__float_as_uint(ps), __float_as_uint(ps), false, false);
    ps = __uint_as_float(rr[0]) + __uint_as_float(rr[1]); }
  l_reg = l_reg * alpha + ps;
#define ATT_PK4(P, BASE, OUT) do { unsigned a0 = cvtpk(P[BASE + 0], P[BASE + 1]), a1 = cvtpk(P[BASE + 2], P[BASE + 3]);   \
    unsigned b0 = cvtpk(P[BASE + 4], P[BASE + 5]), b1 = cvtpk(P[BASE + 6], P[BASE + 7]);                              \
    auto r0 = __builtin_amdgcn_permlane32_swap(a0, b0, false, false); auto r1 = __builtin_amdgcn_permlane32_swap(a1, b1, false, false); \
    u32x4 w = {r0[0], r1[0], r0[1], r1[1]}; OUT = *reinterpret_cast<bf16x8*>(&w); } while (0)
  ATT_PK4(p0, 0, pa0); ATT_PK4(p0, 8, pa1); ATT_PK4(p1, 0, pa2); ATT_PK4(p1, 8, pa3);
#undef ATT_PK4
}
template <int DQK> __device__ __forceinline__ int kswz(int row, int colB) {
  if (DQK == 128) return row * 256 + (colB ^ ((row & 7) << 4));
  return row * 400 + colB;
}
template <int DQK> __device__ __forceinline__ void qkt(f32x16& p0, f32x16& p1, const char* Ks, const bf16x8* qr, int r32, int hi) {
  p0 = f32x16{}; p1 = f32x16{};
#pragma unroll
  for (int d0 = 0; d0 < DQK / 16; ++d0) { const int cb = (d0 * 16 + hi * 8) * 2;
    const bf16x8 b0 = *reinterpret_cast<const bf16x8*>(Ks + kswz<DQK>(r32, cb));
    const bf16x8 b1 = *reinterpret_cast<const bf16x8*>(Ks + kswz<DQK>(32 + r32, cb));
    p0 = __builtin_amdgcn_mfma_f32_32x32x16_bf16(b0, qr[d0], p0, 0, 0, 0);
    p1 = __builtin_amdgcn_mfma_f32_32x32x16_bf16(b1, qr[d0], p1, 0, 0, 0); }
}
__device__ __forceinline__ int v_st(int k, int c) { const int kk = (k & ~0xC) | ((k & 4) << 1) | ((k & 8) >> 1); return ((kk >> 3) * 4 + (c >> 5)) * 512 + ((kk & 7) * 32 + (c & 31)) * 2; }
__device__ __forceinline__ int v_rd_base(int lane) { return ((lane & 3) << 3) | (((lane >> 2) & 3) << 6) | (((lane >> 4) & 1) << 5) | (((lane >> 5) & 1) << 8); }
constexpr int v_rd_off(int d0, int ks, int half) { return d0 * 512 + ks * 4096 + half * 2048; }
template <int OFF> __device__ __forceinline__ s16x4 tr_read(int vb) { s16x4 r; asm volatile("ds_read_b64_tr_b16 %0, %1 offset:%2" : "=&v"(r) : "v"(vb), "i"(OFF) : "memory"); return r; }
template <int D0> __device__ __forceinline__ void pv_one(f32x16& od, int vb, bf16x8 pa0, bf16x8 pa1, bf16x8 pa2, bf16x8 pa3) {
  const s16x4 l0 = tr_read<v_rd_off(D0, 0, 0)>(vb), h0 = tr_read<v_rd_off(D0, 0, 1)>(vb), l1 = tr_read<v_rd_off(D0, 1, 0)>(vb), h1 = tr_read<v_rd_off(D0, 1, 1)>(vb);
  const s16x4 l2 = tr_read<v_rd_off(D0, 2, 0)>(vb), h2 = tr_read<v_rd_off(D0, 2, 1)>(vb), l3 = tr_read<v_rd_off(D0, 3, 0)>(vb), h3 = tr_read<v_rd_off(D0, 3, 1)>(vb);
  asm volatile("s_waitcnt lgkmcnt(0)" ::: "memory"); ATT_SBAR();
#define ATT_PK(L, H) (bf16x8){L[0], L[1], L[2], L[3], H[0], H[1], H[2], H[3]}
  od = __builtin_amdgcn_mfma_f32_32x32x16_bf16(pa0, ATT_PK(l0, h0), od, 0, 0, 0);
  od = __builtin_amdgcn_mfma_f32_32x32x16_bf16(pa1, ATT_PK(l1, h1), od, 0, 0, 0);
  od = __builtin_amdgcn_mfma_f32_32x32x16_bf16(pa2, ATT_PK(l2, h2), od, 0, 0, 0);
  od = __builtin_amdgcn_mfma_f32_32x32x16_bf16(pa3, ATT_PK(l3, h3), od, 0, 0, 0);
#undef ATT_PK
}
__device__ __forceinline__ void pv_d0(f32x16* o, int vb, bf16x8 pa0, bf16x8 pa1, bf16x8 pa2, bf16x8 pa3) {
  pv_one<0>(o[0], vb, pa0, pa1, pa2, pa3); pv_one<1>(o[1], vb, pa0, pa1, pa2, pa3); pv_one<2>(o[2], vb, pa0, pa1, pa2, pa3); pv_one<3>(o[3], vb, pa0, pa1, pa2, pa3);
}
template <int MODE> __device__ __forceinline__ void maskt(f32x16& p0, f32x16& p1, int t, int band0, int qpos, int hi) {
  if (MODE != 1) return;
  if (t < 4) return;
  const int pos0 = band0 + 64 * (t - 4);
#pragma unroll
  for (int r = 0; r < 16; ++r) { const int kp = pos0 + crow(r, hi); const int dq = qpos - kp, dq2 = dq - 32;
    const bool ok0 = (unsigned)kp < (unsigned)SEQ && dq <= 128 && dq >= -128; const bool ok1 = (unsigned)(kp + 32) < (unsigned)SEQ && dq2 <= 128 && dq2 >= -128;
    if (!ok0) p0[r] = -1e30f; if (!ok1) p1[r] = -1e30f; }
}
template <int DQK, int MODE>
__device__ __forceinline__ void attn_unit(const bf16* __restrict__ Qb, int ldq, const bf16* __restrict__ Kp, int ldk, const bf16* __restrict__ Vp, int ldv, bf16* __restrict__ Ob, int ldo,
                                          int NT, int ctx0, int lat0, int band0, int q0, float SCALE, float sinkL2, char* lds) {
  constexpr int SHM_V = KVBLK * 128 * 2, SHM_K = KVBLK * DQK * 2, CH = DQK / 8, NKC = DQK / 64, SDEPTH = (DQK > 128 ? 1 : 2);
  const float C = SCALE * LOG2E, thr = 8.f / SCALE;
  const int tid = threadIdx.x, wid = tid >> 6, lane = tid & 63, r32 = lane & 31, hi = lane >> 5;
  char* V_lds = lds; char* K_lds = lds + 2 * SHM_V;
  float* wsf = (float*)(lds + 2 * SHM_V + 2 * SHM_K) + wid * 64; float* li_l = wsf; float* al_l = wsf + 32;
  float m_reg = -1e30f, l_reg = 0; f32x16 o[4] = {}; bf16x8 qr[DQK / 16];
  const bf16* Qw = Qb + (long)(wid * QBLK + r32) * ldq + hi * 8;
#pragma unroll
  for (int d0 = 0; d0 < DQK / 16; ++d0) qr[d0] = *reinterpret_cast<const bf16x8*>(Qw + d0 * 16);
  const int sr = tid >> 4, sc = (tid & 15) * 8, vst0 = v_st(sr, sc), vst1 = v_st(32 + sr, sc);
  const int vb0 = (int)(uintptr_t)V_lds + v_rd_base(lane);
  int krow[NKC], kcol[NKC];
#pragma unroll
  for (int c = 0; c < NKC; ++c) { const int id = tid + 512 * c; krow[c] = id / CH; kcol[c] = id % CH; }
  struct { bf16x8 vs0, vs1, ks[NKC]; } sr_[SDEPTH];
  const int qpos = q0 + wid * QBLK + r32;
#define ATT_TROW(t) ((t) < 4 ? ctx0 + 64 * (t) : (MODE == 0 ? lat0 + 64 * ((t) - 4) : lat0 + min(max(band0 + 64 * ((t) - 4), 0), SEQ - 64)))
#define ATT_SLOAD(i, t) do { const long row0_ = ATT_TROW(t); sr_[i].vs0 = *reinterpret_cast<const bf16x8*>(&Vp[(row0_ + sr) * ldv + sc]); sr_[i].vs1 = *reinterpret_cast<const bf16x8*>(&Vp[(row0_ + 32 + sr) * ldv + sc]); \
    _Pragma("unroll") for (int c_ = 0; c_ < NKC; ++c_) sr_[i].ks[c_] = *reinterpret_cast<const bf16x8*>(&Kp[(row0_ + krow[c_]) * ldk + kcol[c_] * 8]); } while (0)
#define ATT_SWRITE(b, i) do { *(bf16x8*)(V_lds + (b) * SHM_V + vst0) = sr_[i].vs0; *(bf16x8*)(V_lds + (b) * SHM_V + vst1) = sr_[i].vs1; \
    _Pragma("unroll") for (int c_ = 0; c_ < NKC; ++c_) *(bf16x8*)(K_lds + (b) * SHM_K + kswz<DQK>(krow[c_], kcol[c_] * 16)) = sr_[i].ks[c_]; } while (0)
#define ATT_SWAIT() asm volatile("s_waitcnt vmcnt(%0)" :: "n"(SDEPTH == 2 ? 2 + NKC : 0) : "memory")
#define ATT_RESC(a) do { if (__any((a) < 1.f)) { if (hi == 0) al_l[r32] = (a); asm volatile("s_waitcnt lgkmcnt(0)" ::: "memory"); \
    _Pragma("unroll") for (int d = 0; d < 4; ++d) _Pragma("unroll") for (int r = 0; r < 16; ++r) o[d][r] *= al_l[crow(r, hi)]; } } while (0)
  f32x16 pA0, pA1, pB0, pB1; float mnA, mnB, alA, alB; bf16x8 pa0, pa1, pa2, pa3;
  constexpr int SE = 0, SO = SDEPTH - 1;
  ATT_SLOAD(SE, 0); asm volatile("s_waitcnt vmcnt(0)" ::: "memory"); ATT_SWRITE(0, SE); __syncthreads();
  qkt<DQK>(pA0, pA1, K_lds, qr, r32, hi); maskt<MODE>(pA0, pA1, 0, band0, qpos, hi); partialSM(pA0, pA1, m_reg, mnA, alA, C, thr);
  ATT_SLOAD(SO, 1); if constexpr (SDEPTH == 2) { if (2 < NT) ATT_SLOAD(SE, 2); }
  ATT_SWAIT(); ATT_SWRITE(1, SO); __syncthreads();
  for (int j = 1; j + 1 < NT; j += 2) {
    ATT_SBAR(); qkt<DQK>(pB0, pB1, K_lds + SHM_K, qr, r32, hi); maskt<MODE>(pB0, pB1, j, band0, qpos, hi);
    finishSM(pA0, pA1, alA, l_reg, pa0, pa1, pa2, pa3); ATT_SBAR();
    ATT_SLOAD(SO, j + SDEPTH); ATT_SBAR();
    pv_d0(o, vb0, pa0, pa1, pa2, pa3); partialSM(pB0, pB1, m_reg, mnB, alB, C, thr);
    __syncthreads(); ATT_SWAIT(); ATT_SWRITE(0, SE);
    ATT_RESC(alB); __syncthreads();
    ATT_SBAR(); qkt<DQK>(pA0, pA1, K_lds, qr, r32, hi); maskt<MODE>(pA0, pA1, j + 1, band0, qpos, hi);
    finishSM(pB0, pB1, alB, l_reg, pa0, pa1, pa2, pa3); ATT_SBAR();
    if (SDEPTH == 1 || j + 3 < NT) ATT_SLOAD(SE, j + 1 + SDEPTH); ATT_SBAR();
    pv_d0(o, vb0 + SHM_V, pa0, pa1, pa2, pa3); partialSM(pA0, pA1, m_reg, mnA, alA, C, thr);
    __syncthreads(); ATT_SWAIT(); ATT_SWRITE(1, SO);
    ATT_RESC(alA); __syncthreads();
  }
  ATT_SBAR(); qkt<DQK>(pB0, pB1, K_lds + SHM_K, qr, r32, hi); maskt<MODE>(pB0, pB1, NT - 1, band0, qpos, hi);
  finishSM(pA0, pA1, alA, l_reg, pa0, pa1, pa2, pa3); ATT_SBAR();
  pv_d0(o, vb0, pa0, pa1, pa2, pa3); partialSM(pB0, pB1, m_reg, mnB, alB, C, thr);
  __syncthreads(); ATT_RESC(alB);
  finishSM(pB0, pB1, alB, l_reg, pa0, pa1, pa2, pa3); ATT_SBAR();
  pv_d0(o, vb0 + SHM_V, pa0, pa1, pa2, pa3);
  if (MODE == 1) l_reg += __builtin_amdgcn_exp2f(sinkL2 - m_reg * C);
  if (hi == 0) li_l[r32] = l_reg; asm volatile("s_waitcnt lgkmcnt(0)" ::: "memory");
  float rli[16];
#pragma unroll
  for (int r = 0; r < 16; ++r) rli[r] = __builtin_amdgcn_rcpf(li_l[crow(r, hi)]);
  bf16* Ow = Ob + (long)(wid * QBLK) * ldo;
#pragma unroll
  for (int r = 0; r < 16; ++r) { const int orow = crow(r, hi);
#pragma unroll
    for (int d0 = 0; d0 < 4; ++d0) Ow[(long)orow * ldo + d0 * 32 + r32] = f2bf(o[d0][r] * rli[r]); }
  __syncthreads();
#undef ATT_TROW
#undef ATT_SLOAD
#undef ATT_SWRITE
#undef ATT_SWAIT
#undef ATT_RESC
}

template <int DQK, int MODE, bool EARLY, int QP = 0>
__device__ __forceinline__ void attn_unit_simple(const bf16* __restrict__ Qb, int ldq, const bf16* __restrict__ Kp, int ldk, const bf16* __restrict__ Vp, int ldv, bf16* __restrict__ Ob, int ldo,
                                                 int NT, int ctx0, int lat0, int band0, int q0, float SCALE, float sinkL2, char* lds, float fixref = 0.f,
                                                 const float* __restrict__ qkg = nullptr, const float* __restrict__ tab = nullptr, float qscale = 1.f, int qrow0 = 0) {
  constexpr int SHM_V = KVBLK * 128 * 2, SHM_K = KVBLK * (DQK == 128 ? 256 : 400), CH = DQK / 8, NKC = DQK / 64;
  const float C = SCALE * LOG2E, thr = 8.f / SCALE;
  int tid_ = threadIdx.x; asm volatile("" : "+v"(tid_));
  const int tid = tid_, wid = tid >> 6, lane = tid & 63, r32 = lane & 31, hi = lane >> 5;
  char* V_lds = lds; char* K_lds = lds + 2 * SHM_V;
  float* wsf = (float*)(lds + 2 * SHM_V + 2 * SHM_K) + wid * 64; float* li_l = wsf; float* al_l = wsf + 32;
  float m_reg = -1e30f, l_reg = 0; f32x16 o[4] = {}; bf16x8 qr[DQK / 16];
  const bf16* Qw = Qb + (long)(wid * QBLK + r32) * ldq + hi * 8;
#pragma unroll
  for (int d0 = 0; d0 < DQK / 16; ++d0) qr[d0] = *reinterpret_cast<const bf16x8*>(Qw + d0 * 16);
  const int sr = tid >> 4, sc = (tid & 15) * 8, vst0 = v_st(sr, sc), vst1 = v_st(32 + sr, sc);
  const int vb0 = (int)(uintptr_t)V_lds + v_rd_base(lane);
  int krow[NKC], kcol[NKC];
#pragma unroll
  for (int c = 0; c < NKC; ++c) { const int id = tid + 512 * c; krow[c] = id / CH; kcol[c] = id % CH; }
  bf16x8 vs0, vs1, ksg[NKC];
  const int qpos = q0 + wid * QBLK + r32;
#define ATT_TROW(t) ((t) < 4 ? ctx0 + 64 * (t) : (MODE == 0 ? lat0 + 64 * ((t) - 4) : lat0 + min(max(band0 + 64 * ((t) - 4), 0), SEQ - 64)))
#define ATT_SLOAD(t) do { const long row0_ = ATT_TROW(t); vs0 = *reinterpret_cast<const bf16x8*>(&Vp[(row0_ + sr) * ldv + sc]); vs1 = *reinterpret_cast<const bf16x8*>(&Vp[(row0_ + 32 + sr) * ldv + sc]); \
    _Pragma("unroll") for (int c_ = 0; c_ < NKC; ++c_) ksg[c_] = *reinterpret_cast<const bf16x8*>(&Kp[(row0_ + krow[c_]) * ldk + kcol[c_] * 8]); } while (0)
#define ATT_SWRITE(b) do { *(bf16x8*)(V_lds + (b) * SHM_V + vst0) = vs0; *(bf16x8*)(V_lds + (b) * SHM_V + vst1) = vs1; \
    _Pragma("unroll") for (int c_ = 0; c_ < NKC; ++c_) *(bf16x8*)(K_lds + (b) * SHM_K + kswz<DQK>(krow[c_], kcol[c_] * 16)) = ksg[c_]; } while (0)
  ATT_SLOAD(0);
  if constexpr (QP == 1) {
    int hi8 = hi * 8; asm volatile("" : "+v"(hi8));
    float sn_ = 0.f, sr_ = 0.f;
#pragma unroll
    for (int d0 = 0; d0 < 12; ++d0) { float f[8]; unpack8(__builtin_bit_cast(u32x4, qr[d0]), f);
#pragma unroll
      for (int e = 0; e < 8; ++e) { if (d0 < 8) sn_ += f[e] * f[e]; else sr_ += f[e] * f[e]; } }
    { auto r0_ = __builtin_amdgcn_permlane32_swap(__float_as_uint(sn_), __float_as_uint(sn_), false, false); sn_ = __uint_as_float(r0_[0]) + __uint_as_float(r0_[1]);
      auto r1_ = __builtin_amdgcn_permlane32_swap(__float_as_uint(sr_), __float_as_uint(sr_), false, false); sr_ = __uint_as_float(r1_[0]) + __uint_as_float(r1_[1]); }
    const float rn = frsq(sn_ * (1.f / 128.f) + EPS), rr = frsq(sr_ * (1.f / 64.f) + EPS);
#pragma unroll
    for (int d0 = 0; d0 < 8; ++d0) { float f[8]; unpack8(__builtin_bit_cast(u32x4, qr[d0]), f); const float* gp = qkg + 16 * d0 + hi8; const f32x4 g0 = *(const f32x4*)gp, g1 = *(const f32x4*)(gp + 4);
#pragma unroll
      for (int e = 0; e < 4; ++e) { f[e] = f[e] * rn * (g0[e] * qscale); f[4 + e] = f[4 + e] * rn * (g1[e] * qscale); }
      qr[d0] = __builtin_bit_cast(bf16x8, pack8(f)); }
    const int m_ = qrow0 + wid * QBLK + r32; const bool isl = m_ < MLAT; const int t_ = m_ & (SEQ - 1);
#pragma unroll
    for (int blk = 0; blk < 2; ++blk) { float fa[8], fb[8]; unpack8(__builtin_bit_cast(u32x4, qr[8 + 2 * blk]), fa); unpack8(__builtin_bit_cast(u32x4, qr[9 + 2 * blk]), fb);
      const float* ga = qkg + 128 + 32 * blk + hi8; const int pos = blk == 0 ? (t_ >> 6) : (t_ & 63);
      const float* tc = tab + (blk == 0 ? T_MC_R : T_MC_C) + pos * 16 + hi8; const float* ts = tab + (blk == 0 ? T_MS_R : T_MS_C) + pos * 16 + hi8;
      const f32x4 gA[2] = {((const f32x4*)ga)[0], ((const f32x4*)ga)[1]}, gB[2] = {((const f32x4*)(ga + 16))[0], ((const f32x4*)(ga + 16))[1]};
      const f32x4 cv[2] = {((const f32x4*)tc)[0], ((const f32x4*)tc)[1]}, sv[2] = {((const f32x4*)ts)[0], ((const f32x4*)ts)[1]};
#pragma unroll
      for (int e = 0; e < 8; ++e) { const float ya = fa[e] * rr * (gA[e >> 2][e & 3] * qscale), yb = fb[e] * rr * (gB[e >> 2][e & 3] * qscale);
        const float cs = isl ? cv[e >> 2][e & 3] : 1.f, sn = isl ? sv[e >> 2][e & 3] : 0.f;
        fa[e] = ya * cs - yb * sn; fb[e] = ya * sn + yb * cs; }
      qr[8 + 2 * blk] = __builtin_bit_cast(bf16x8, pack8(fa)); qr[9 + 2 * blk] = __builtin_bit_cast(bf16x8, pack8(fb)); }
  }
  if constexpr (QP == 2) {
    int hi8 = hi * 8; asm volatile("" : "+v"(hi8));
    float ss_ = 0.f;
#pragma unroll
    for (int d0 = 0; d0 < 8; ++d0) { float f[8]; unpack8(__builtin_bit_cast(u32x4, qr[d0]), f);
#pragma unroll
      for (int e = 0; e < 8; ++e) ss_ += f[e] * f[e]; }
    { auto r0_ = __builtin_amdgcn_permlane32_swap(__float_as_uint(ss_), __float_as_uint(ss_), false, false); ss_ = __uint_as_float(r0_[0]) + __uint_as_float(r0_[1]); }
    const float rn = frsq(ss_ * (1.f / 128.f) + EPS);
    const int t_ = (qrow0 + wid * QBLK + r32) & (SEQ - 1);
#pragma unroll
    for (int blk = 0; blk < 2; ++blk) { const int pos = blk == 0 ? (t_ >> 6) : (t_ & 63);
#pragma unroll
      for (int dd = 0; dd < 2; ++dd) { float fa[8], fb[8]; unpack8(__builtin_bit_cast(u32x4, qr[4 * blk + dd]), fa); unpack8(__builtin_bit_cast(u32x4, qr[4 * blk + 2 + dd]), fb);
        const float* ga = qkg + 64 * blk + 16 * dd + hi8; const float* tc = tab + (blk == 0 ? T_SC_R : T_SC_C) + pos * 32 + 16 * dd + hi8; const float* ts = tab + (blk == 0 ? T_SS_R : T_SS_C) + pos * 32 + 16 * dd + hi8;
        const f32x4 gA[2] = {((const f32x4*)ga)[0], ((const f32x4*)ga)[1]}, gB[2] = {((const f32x4*)(ga + 32))[0], ((const f32x4*)(ga + 32))[1]};
        const f32x4 cv[2] = {((const f32x4*)tc)[0], ((const f32x4*)tc)[1]}, sv[2] = {((const f32x4*)ts)[0], ((const f32x4*)ts)[1]};
#pragma unroll
        for (int e = 0; e < 8; ++e) { const float ya = fa[e] * rn * (gA[e >> 2][e & 3] * qscale), yb = fb[e] * rn * (gB[e >> 2][e & 3] * qscale); const float cs = cv[e >> 2][e & 3], sn = sv[e >> 2][e & 3]; fa[e] = ya * cs - yb * sn; fb[e] = ya * sn + yb * cs; }
        qr[4 * blk + dd] = __builtin_bit_cast(bf16x8, pack8(fa)); qr[4 * blk + 2 + dd] = __builtin_bit_cast(bf16x8, pack8(fb)); } }
  }
  f32x16 p0, p1; float mn, al; bf16x8 pa0, pa1, pa2, pa3;
  ATT_SWRITE(0); if (EARLY && 1 < NT) ATT_SLOAD(1); __syncthreads();
  for (int t = 0; t < NT; ++t) {
    const int bsel = t & 1;
    ATT_SBAR();
    qkt<DQK>(p0, p1, K_lds + bsel * SHM_K, qr, r32, hi); maskt<MODE>(p0, p1, t, band0, qpos, hi);
    partialSM(p0, p1, m_reg, mn, al, C, thr, fixref); finishSM(p0, p1, al, l_reg, pa0, pa1, pa2, pa3);
    if (__any(al < 1.f)) { if (hi == 0) al_l[r32] = al; asm volatile("s_waitcnt lgkmcnt(0)" ::: "memory");
#pragma unroll
      for (int d = 0; d < 4; ++d)
#pragma unroll
        for (int r = 0; r < 16; ++r) o[d][r] *= al_l[crow(r, hi)]; }
    ATT_SBAR();
    if (!EARLY && t + 1 < NT) ATT_SLOAD(t + 1);
    if (EARLY && t + 1 < NT) { ATT_SWRITE(bsel ^ 1); if (t + 2 < NT) ATT_SLOAD(t + 2); }
    ATT_SBAR();
    pv_d0(o, vb0 + bsel * SHM_V, pa0, pa1, pa2, pa3);
    if (!EARLY && t + 1 < NT) ATT_SWRITE(bsel ^ 1);
    __syncthreads();
  }
  if (MODE == 1) l_reg += __builtin_amdgcn_exp2f(sinkL2 - (fixref > 0.f ? 0.f : m_reg * C));
  if (hi == 0) li_l[r32] = l_reg; asm volatile("s_waitcnt lgkmcnt(0)" ::: "memory");
  float rli[16];
#pragma unroll
  for (int r = 0; r < 16; ++r) rli[r] = __builtin_amdgcn_rcpf(li_l[crow(r, hi)]);
  bf16* Ow = Ob + (long)(wid * QBLK) * ldo;
  {
    char* Ost = lds + wid * 8192;
#pragma unroll
    for (int r = 0; r < 16; ++r) { const int orow = crow(r, hi);
#pragma unroll
      for (int d0 = 0; d0 < 4; ++d0) *(unsigned short*)(Ost + orow * 256 + (d0 * 32 + r32) * 2) = f2bf(o[d0][r] * rli[r]); }
    asm volatile("s_waitcnt lgkmcnt(0)" ::: "memory");
#pragma unroll
    for (int k = 0; k < 8; ++k) { const int pc = k * 64 + lane, row = pc >> 4, c = pc & 15;
      *(u32x4*)(Ow + (long)row * ldo + c * 8) = *(const u32x4*)(Ost + row * 256 + c * 16); }
  }
  __syncthreads();
#undef ATT_TROW
#undef ATT_SLOAD
#undef ATT_SWRITE
}
}

struct Args { const float* in[N_IN]; float* out; unsigned char* ws; int ph_lo, ph_hi; };
#ifdef PROBE_MODE
constexpr int N_PHASES = 40;
#else
constexpr int N_PHASES = 39;
#endif

__global__ void __launch_bounds__(NTHR, 2) fwd_kernel(Args args) {
    extern __shared__ __attribute__((aligned(16))) unsigned char lds_raw[];
    LAS unsigned char* lds = (LAS unsigned char*)lds_raw;
#define tid ((int)threadIdx.x)
#define lane ((int)(threadIdx.x & 63))
#define wave (__builtin_amdgcn_readfirstlane((int)(threadIdx.x >> 6)))
#define G ((int)gridDim.x)
#define bid ((int)blockIdx.x)
#define gw (bid * NWAVES + wave)
#define NGW (G * NWAVES)
#define gt (bid * NTHR + tid)
#define NGT (G * NTHR)
    unsigned char* ws = args.ws; const float* const* in = args.in;
    volatile LAS unsigned* MISC = (volatile LAS unsigned*)(lds + MISC_OFF);
    for (int u = tid; u < (LDS_BYTES - MISC_OFF) / 4; u += NTHR) ((LAS unsigned*)(lds + MISC_OFF))[u] = 0u;
    __syncthreads();
    const int lo = args.ph_lo, hi = args.ph_hi;
    const bool one_launch = (hi - lo) > 1;
    XcdBarrier bar; bar.bar = (unsigned*)(ws + WS_CTL) + CW_BAR; bar.x = 0; bar.st = MISC + 8;
    if (one_launch) bar = xcd_barrier_post((unsigned*)(ws + WS_CTL) + CW_BAR, MISC + 8);
#ifndef ONLY
#define ONLY -1
#endif
#define IN(k) ((ONLY < 0 || ONLY == (k)) && lo <= (k) && (k) < hi)
#ifndef DUP_MASK
#define DUP_MASK(k) 0
#endif
#define REP(k) for (int rep_ = 0; rep_ < 1 + (DUP_MASK(k)); ++rep_)
#define SEAM(k) do { if (IN(k) && IN((k) + 1)) xcd_barrier(bar); } while (0)
    float* xlat = args.out; float* xctx = (float*)(ws + WS_XC);
    const float* modv = (const float*)(ws + WS_MODV); const float* tab = (const float*)(ws + WS_TAB);
    bf16* Hb = (bf16*)(ws + WS_H);
    bf16* HID = (bf16*)(ws + B_HID);
#define scr ((LAS float*)(lds + wave * 16384))

#ifndef PG_ALIGN
#define PG_ALIGN true
#endif
#ifndef PG_SP2
#define PG_SP2 true
#endif
#define GEMM_STORE(Aptr, Wptr, Mr, Nn, Kk, Optr, ldc_, splitc, splits) GEMM_STORE_C(Aptr, Wptr, Mr, Nn, Kk, Optr, ldc_, splitc, splits, bid)
#define GEMM_STORE_C(Aptr, Wptr, Mr, Nn, Kk, Optr, ldc_, splitc, splits, cc_) do { pg8::Gemm g_{(const pg8::bf16_t*)(Aptr), (const pg8::bf16_t*)(Wptr), (Mr), (Nn), (Kk), (Kk)}; pg8::StaticOrder S_; S_.init((Mr), (Nn), G, (cc_), WGM_ST); \
        pg8::EpiBf16<0> E_{(pg8::bf16_t*)(Optr), (ldc_), nullptr, (splitc), (splits), 1.f}; pg8::gemm_phase<pg8::EpiBf16<0>, pg8::StaticOrder, PG_ALIGN, PG_SP2>(lds, g_, S_, E_); } while (0)
#define GEMM_RESID(Aptr, Wptr, Mr, Kk, srcl, layer, chunk, ksplit) do { \
        if ((Mr) > MLAT) { pg8::Gemm g_{(const pg8::bf16_t*)(Aptr), (const pg8::bf16_t*)(Wptr), MROWS, DM, (Kk) / (ksplit), (Kk)}; pg8::CtxSplitOrder S_{(ksplit), (Kk) / (ksplit), G, bid}; \
        pg8::EpiPartial E_{(float*)(ws + B_PART), (Kk) / (ksplit)}; pg8::gemm_phase<pg8::EpiPartial, pg8::CtxSplitOrder, PG_ALIGN, PG_SP2>(lds, g_, S_, E_); } \
        { pg8::Gemm g_{(const pg8::bf16_t*)(Aptr), (const pg8::bf16_t*)(Wptr), MLAT, DM, (Kk), (Kk)}; pg8::StaticOrder S_; S_.init(MLAT, DM, G, bid, WGM_RES, 0, (Kk) == FFH); \
        pg8::EpiResid E_{(srcl), xctx, xlat, xctx, modv + (size_t)(layer) * 3 * 12288 + (chunk) * DM}; pg8::gemm_phase<pg8::EpiResid, pg8::StaticOrder, PG_ALIGN, PG_SP2>(lds, g_, S_, E_); } } while (0)
#ifndef WGM_RES
#define WGM_RES 4
#endif
#ifndef WGM_ST
#define WGM_ST 4
#endif
#ifndef WGM_FUP
#define WGM_FUP 4
#endif
#define FFN_UP(Mr) do { pg8::Gemm g_{(const pg8::bf16_t*)Hb, (const pg8::bf16_t*)(ws + W_FUP), (Mr), 2 * FFH, DM, DM}; pg8::StaticOrder S_; S_.init((Mr), 2 * FFH, G, bid, WGM_FUP); \
        pg8::EpiSwiglu E_{(pg8::bf16_t*)HID, FFH}; pg8::gemm_phase<pg8::EpiSwiglu, pg8::StaticOrder, PG_ALIGN, PG_SP2>(lds, g_, S_, E_); } while (0)
#define NORM(srcl, srcc, layer, which, Mr, ns, pl, pch) norm_phase((srcl), (srcc), in[I_NORMG] + ((layer) * 2 + (which)) * DM, modv + (size_t)(layer) * 3 * 12288, (which), Hb, (Mr), gw, NGW, lane, \
        (ns) ? (const float*)(ws + B_PART) : nullptr, (ns), modv + (size_t)(pl) * 3 * 12288 + 2 * 12288 + (pch) * DM, xctx)

    if (IN(0)) REP(0) { prologue(in, ws, lds, bid, G, tid); } SEAM(0);
    if (IN(1)) REP(1) { NORM(in[I_X], in[I_CTX], 0, 0, MROWS, 0, 0, 0); } SEAM(1);
    if (IN(2)) REP(2) { GEMM_STORE(Hb, ws + W_RGWI, MROWS, 4096, DM, ws + B_GR, 4096, 0, 0); } SEAM(2);
    if (IN(3)) REP(3) { rglru_items<1>((const bf16*)(ws + B_GR), in[I_RGCW], in[I_RGCB], (const bf16*)(ws + W_RGG), in[I_RGGB], in[I_RGLAM], (float*)(ws + B_CARRY), nullptr, nullptr, lds, bid, G, tid); } SEAM(3);
    if (IN(4)) REP(4) { rglru_prop((const float*)(ws + B_CARRY), (float*)(ws + B_HIN), (LAS float*)lds, bid, G, tid); } SEAM(4);
    if (IN(5)) REP(5) { rglru_items<2>((const bf16*)(ws + B_GR), in[I_RGCW], in[I_RGCB], (const bf16*)(ws + W_RGG), in[I_RGGB], in[I_RGLAM], nullptr, (const float*)(ws + B_HIN), Hb, lds, bid, G, tid); } SEAM(5);
    if (IN(6)) { GEMM_RESID(Hb, ws + W_RGWO, MROWS, DM, in[I_X], 0, 2, 8); } SEAM(6);
    if (IN(7)) REP(7) { NORM(xlat, in[I_CTX], 0, 1, MROWS, 8, 0, 2); } SEAM(7);
    if (IN(8)) REP(8) { FFN_UP(MROWS); } SEAM(8);
    if (IN(9)) { GEMM_RESID(HID, ws + W_FDN, MROWS, FFH, xlat, 0, 5, 11); } SEAM(9);
    if (IN(10)) REP(10) { NORM(xlat, xctx, 1, 0, MROWS, 11, 0, 5); __syncthreads(); cvt_ffn(in[I_FFNWI], in[I_FFNWO], 1, ws, scr, gw, NGW, lane); } SEAM(10);
    if (IN(11)) REP(11) { GEMM_STORE(Hb, ws + W_HGWI, MROWS, 10240, DM, ws + B_HG, DM, DM, (size_t)MROWS * DM); } SEAM(11);
    if (IN(12)) REP(12) { gla_items<1>((const bf16*)(ws + B_HG), tab + T_LB, (float*)(ws + B_ST), (float*)(ws + B_DV), nullptr, nullptr, lds, bid, G, tid); } SEAM(12);
    if (IN(13)) { gla_prop((float*)(ws + B_ST), (const float*)(ws + B_DV), gt, NGT); } SEAM(13);
    if (IN(14)) REP(14) { gla_items<2>((const bf16*)(ws + B_HG), tab + T_LB, (float*)(ws + B_ST), (float*)(ws + B_DV), (bf16*)(ws + B_OF), (bf16*)(ws + B_OB), lds, bid, G, tid); } SEAM(14);
    if (IN(15)) REP(15) { gla_final((const bf16*)(ws + B_OF), (const bf16*)(ws + B_OB), (const bf16*)(ws + B_HG) + 4 * (size_t)MROWS * DM, in[I_HGGN], Hb, gw, NGW, lane); } SEAM(15);
    if (IN(16)) { GEMM_RESID(Hb, ws + W_HGWO, MROWS, DM, xlat, 1, 2, 8); } SEAM(16);
    if (IN(17)) REP(17) { NORM(xlat, xctx, 1, 1, MROWS, 8, 1, 2); } SEAM(17);
    if (IN(18)) REP(18) { FFN_UP(MROWS); } SEAM(18);
    if (IN(19)) { GEMM_RESID(HID, ws + W_FDN, MROWS, FFH, xlat, 1, 5, 11); } SEAM(19);
    if (IN(20)) REP(20) { NORM(xlat, xctx, 2, 0, MROWS, 11, 1, 5); __syncthreads(); cvt_ffn(in[I_FFNWI], in[I_FFNWO], 2, ws, scr, gw, NGW, lane); } SEAM(20);
    if (IN(21)) REP(21) { GEMM_STORE(Hb, ws + W_MLWI, MROWS, 1280, DM, ws + B_MLC, 1280, 0, 0); } SEAM(21);
    if (IN(22)) REP(22) { mla_prep1((const bf16*)(ws + B_MLC), in[I_MLQN], in[I_MLKVN], in[I_MLQKG], tab, (bf16*)(ws + B_CQN), (bf16*)(ws + B_CKVN), (bf16*)(ws + B_KR), gw, NGW, lane); } SEAM(22);
    if (IN(23)) REP(23) { GEMM_STORE(ws + B_CQN, ws + W_MLUQ, MROWS, 3072, 512, ws + B_Q, 3072, 0, 0); }
    if (IN(24)) REP(24) { GEMM_STORE_C(ws + B_CKVN, ws + W_MLUKV, MROWS, 4096, 512, ws + B_KV, 4096, 0, 0, (G & 15) == 0 ? (bid + G / 2) % G : bid); } SEAM(24);
    if (IN(25)) { mla_prep2((bf16*)(ws + B_Q), (const bf16*)(ws + B_KV), (const bf16*)(ws + B_KR), (bf16*)(ws + B_KN), in[I_MLQKG], tab, gw, NGW, lane, tab[T_MFIX] > 0.f ? 0.07216878364870322f * LOG2E : 1.f); } SEAM(25);
    if (IN(26)) REP(26) {
        const bf16* Q = (const bf16*)(ws + B_Q); const bf16* KN = (const bf16*)(ws + B_KN); const bf16* KV = (const bf16*)(ws + B_KV);
        const int nu = 2048 + 32;
        for (int i = 0; bid + i * G < nu; ++i) {
            const int u = bid + i * G; int bh, qb, NT, row0;
            if (u < 2048) { if (G == 256) { bh = (bid & 7) + 8 * (i >> 1); qb = (i & 1) * 32 + (bid >> 3); } else { bh = u >> 6; qb = u & 63; } NT = 260; row0 = (bh >> 4) * SEQ + qb * 256; }
            else { bh = u - 2048; NT = 4; row0 = MLAT + (bh >> 4) * CTXL; }
            const int b = bh >> 4, h = bh & 15;
            att::attn_unit_simple<192, 0, true, 1>(Q + (size_t)row0 * 3072 + h * 192, 3072, KN + h * 192, 3072, KV + h * 256 + 128, 4096, Hb + (size_t)row0 * DM + h * 128, DM, NT, MLAT + b * CTXL, b * SEQ, 0, 0, 0.07216878364870322f, 0.f, (char*)lds_raw, tab[T_MFIX],
                in[I_MLQKG], tab, tab[T_MFIX] > 0.f ? 0.07216878364870322f * LOG2E : 1.f, row0);
        }
    } SEAM(26);
    if (IN(27)) { GEMM_RESID(Hb, ws + W_MLWO, MROWS, DM, xlat, 2, 2, 8); } SEAM(27);
    if (IN(28)) REP(28) { NORM(xlat, xctx, 2, 1, MROWS, 8, 2, 2); } SEAM(28);
    if (IN(29)) REP(29) { FFN_UP(MROWS); } SEAM(29);
    if (IN(30)) { GEMM_RESID(HID, ws + W_FDN, MROWS, FFH, xlat, 2, 5, 11); } SEAM(30);
#ifdef JUNK_THIN
    if (IN(31)) {
        if (JUNK_THIN & 1) mla_prep2((bf16*)(ws + B_Q), (const bf16*)(ws + B_KV), (const bf16*)(ws + B_KR), (bf16*)(ws + B_KN), in[I_MLQKG], tab, gw, NGW, lane, tab[T_MFIX] > 0.f ? 0.07216878364870322f * LOG2E : 1.f);
        if (JUNK_THIN & 2) swa_prep((bf16*)(ws + B_KV), in[I_SWQKG], tab, gw, NGW, lane);
        if (JUNK_THIN & 4) gla_prop((float*)(ws + B_ST), (const float*)(ws + B_DV), gt, NGT);
        xcd_barrier(bar);
    }
#endif
    if (IN(31)) REP(31) { NORM(xlat, xctx, 3, 0, MROWS, 11, 2, 5); __syncthreads(); cvt_ffn(in[I_FFNWI], in[I_FFNWO], 3, ws, scr, gw, NGW, lane); } SEAM(31);
    if (IN(32)) REP(32) { GEMM_STORE(Hb, ws + W_SWWI, MLAT, 3072, DM, ws + B_QKV, 3072, 0, 0);
        { pg8::Gemm g_{(const pg8::bf16_t*)Hb, (const pg8::bf16_t*)(ws + W_SWWI), MROWS, 3072, DM / 8, DM}; pg8::CtxKVOrder S_{8, DM / 8, G, bid}; pg8::EpiPartialKV E_{(float*)(ws + B_PART), DM / 8};
          pg8::gemm_phase<pg8::EpiPartialKV, pg8::CtxKVOrder, PG_ALIGN, PG_SP2>(lds, g_, S_, E_); } } SEAM(32);
    if (IN(33)) { swa_prep((bf16*)(ws + B_QKV), in[I_SWQKG], tab, (const float*)(ws + B_PART), gw, NGW, lane); } SEAM(33);
    if (IN(34)) REP(34) {
        const bf16* QKV = (const bf16*)(ws + B_QKV);
        for (int u = bid; u < 2048; u += G) { const int b = u >> 10, h = (u >> 6) & 15, qb = u & 63, kvh = h >> 2; const int row0 = b * SEQ + qb * 256;
            att::attn_unit_simple<128, 1, true, 2>(QKV + (size_t)row0 * 3072 + h * 128, 3072, QKV + 2048 + kvh * 128, 3072, QKV + 2560 + kvh * 128, 3072, Hb + (size_t)row0 * DM + h * 128, DM, 12, MLAT + b * CTXL, b * SEQ, qb * 256 - 128, qb * 256,
                                   0.08838834764831845f, in[I_SWSINK][h] * LOG2E, (char*)lds_raw, tab[T_SFIX], in[I_SWQKG], tab, tab[T_SFIX] > 0.f ? 0.08838834764831845f * LOG2E : 1.f, row0); }
    } SEAM(34);
    if (IN(35)) { GEMM_RESID(Hb, ws + W_SWWO, MLAT, DM, xlat, 3, 2, 8); } SEAM(35);
    if (IN(36)) REP(36) { NORM(xlat, xctx, 3, 1, MLAT, 0, 0, 0); } SEAM(36);
    if (IN(37)) REP(37) { FFN_UP(MLAT); } SEAM(37);
    if (IN(38)) { GEMM_RESID(HID, ws + W_FDN, MLAT, FFH, xlat, 3, 5, 11); } SEAM(38);
#ifdef EXTRA_BARRIERS
    if (IN(38)) { for (int xb_ = 0; xb_ < EXTRA_BARRIERS; ++xb_) xcd_barrier(bar); }
#endif
#ifdef JUNK_GEMM
    {
        float* jl = (float*)(ws + WS_BIG + 400 * MiB); float* jc = jl + (size_t)MLAT * DM;
        { xcd_barrier(bar); pg8::Gemm g_{(const pg8::bf16_t*)(JUNK_A), (const pg8::bf16_t*)(JUNK_W), MROWS, DM, JUNK_K, JUNK_K}; pg8::StaticOrder S_; S_.init(MROWS, DM, G, bid);
            pg8::EpiResid E_{jl, jc, jl, jc, modv}; pg8::gemm_phase<pg8::EpiResid, pg8::StaticOrder, PG_ALIGN, PG_SP2>(lds, g_, S_, E_); }
    }
#endif
#ifdef PROBE_MODE
    if (IN(39)) {
        for (size_t i = gt; i < (size_t)MLAT * DM / 4; i += NGT) { const int row = (int)(i >> 9), c4 = (int)(i & 511) * 4; f32x4 v = ((f32x4*)xlat)[i];
            { const float d0 = PROBE_D(row, c4 + 0), d1 = PROBE_D(row, c4 + 1), d2 = PROBE_D(row, c4 + 2), d3 = PROBE_D(row, c4 + 3); v.x += d0; v.y += d1; v.z += d2; v.w += d3; }
            ((f32x4*)xlat)[i] = v; }
    }
#endif
#undef IN
#undef SEAM
#undef tid
#undef lane
#undef wave
#undef G
#undef bid
#undef gw
#undef NGW
#undef gt
#undef NGT
}

#ifndef MK_N_LAUNCHES
#define MK_N_LAUNCHES 1
#endif
extern "C" void kernel_launch(void* const* d_in, const int* in_sizes, int n_in, void* d_out, int out_size, void* d_ws, size_t ws_size, hipStream_t stream) {
    static int grid = 0;
    if (grid == 0) {
        if (n_in != N_IN || out_size != MLAT * DM || ws_size < (size_t)1532 * MiB) { fprintf(stderr, "kernel_launch: unexpected shapes: n_in %d out %d ws %zu (need %zu)\n", n_in, out_size, ws_size, (size_t)WS_END); grid = -1; return; }
        int dev = 0, cus = 0, per_cu = 0;
        if (hipGetDevice(&dev) != hipSuccess || hipDeviceGetAttribute(&cus, hipDeviceAttributeMultiprocessorCount, dev) != hipSuccess) { grid = -1; return; }
        if (hipFuncSetAttribute((const void*)fwd_kernel, hipFuncAttributeMaxDynamicSharedMemorySize, LDS_BYTES) != hipSuccess) { fprintf(stderr, "kernel_launch: hipFuncSetAttribute failed\n"); grid = -1; return; }
        if (hipOccupancyMaxActiveBlocksPerMultiprocessor(&per_cu, (const void*)fwd_kernel, NTHR, LDS_BYTES) != hipSuccess || per_cu < 1) fprintf(stderr, "kernel_launch: occupancy query reports %d\n", per_cu);
        (void)hipGetLastError();
        grid = cus;
    }
    if (grid < 0) return;
    if (hipMemsetAsync((char*)d_ws + WS_CTL, 0, CTL_ZERO_BYTES, stream) != hipSuccess) return;
    Args a{};
    for (int i = 0; i < N_IN; ++i) a.in[i] = (const float*)d_in[i];
    a.out = (float*)d_out; a.ws = (unsigned char*)d_ws;
    if (MK_N_LAUNCHES == 1) { a.ph_lo = 0; a.ph_hi = N_PHASES; hipLaunchKernelGGL(fwd_kernel, dim3(grid), dim3(NTHR), LDS_BYTES, stream, a); }
    else { for (int p = 0; p < N_PHASES; ++p) { a.ph_lo = p; a.ph_hi = p + 1; hipLaunchKernelGGL(fwd_kernel, dim3(grid), dim3(NTHR), LDS_BYTES, stream, a); } }
    const hipError_t le = hipPeekAtLastError();
    if (le != hipSuccess) fprintf(stderr, "kernel_launch: launch failed: %s\n", hipGetErrorName(le));
}
```
